# Optimizing an MI355X kernel written in HIP

```python
import math
import jax, jax.numpy as jnp
from jax import lax
import numpy as np

D_MODEL = 1024
BATCH = 8
SEQ = 2048
DEPTH = 1

MEM_LEN = 256
DN_HEADS = 8
DN_DK = 128
DN_DV = 128
DN_CHUNK = 64
CONV_K = 4
SB_HEADS = 8
SB_DH = 128
SB_BLOCK = 128
MEM_HEADS = 4
MEM_DH = 64
N_BRANCH = 3
NORM_EPS = 1e-6

DN_QK = DN_HEADS * DN_DK
DN_VW = DN_HEADS * DN_DV
DN_QKV_W = 2 * DN_QK + DN_VW
SB_W = SB_HEADS * SB_DH
MEM_W = MEM_HEADS * MEM_DH
IN_SIZES = (DN_QKV_W, DN_VW, DN_HEADS, DN_HEADS, 3 * SB_W, SB_W, MEM_W, MEM_W, N_BRANCH * D_MODEL)
IN_WIDTH = sum(IN_SIZES)

kernel_name = "hybrid_deltanet_stickbreak_memory_block"


def rmsnorm(x, g):
    xf = x.astype(jnp.float32)
    y = xf * lax.rsqrt(jnp.mean(xf * xf, axis=-1, keepdims=True) + NORM_EPS)
    return (y * g.astype(jnp.float32)).astype(x.dtype)


def l2norm(x):
    return x * lax.rsqrt(jnp.sum(x * x, axis=-1, keepdims=True) + NORM_EPS)


def to_heads(t, n_heads):
    b, s, _ = t.shape
    return t.reshape(b, s, n_heads, -1).transpose(0, 2, 1, 3)


def merge_heads(t):
    b, h, s, d = t.shape
    return t.transpose(0, 2, 1, 3).reshape(b, s, h * d)


def causal_dwconv(x, w):
    k = w.shape[0]
    t = x.shape[1]
    xp = jnp.pad(x, ((0, 0), (k - 1, 0), (0, 0)))
    return sum(xp[:, j:j + t] * w[j] for j in range(k))


def gated_delta_rule(q, k, v, beta, g):
    b, h, t, dk = q.shape
    dv = v.shape[-1]
    c = DN_CHUNK
    n = t // c
    q = q.reshape(b, h, n, c, dk)
    k = k.reshape(b, h, n, c, dk)
    v = v.reshape(b, h, n, c, dv)
    beta = beta.reshape(b, h, n, c)
    G = jnp.cumsum(g.reshape(b, h, n, c), axis=-1)
    idx = jnp.arange(c)
    incl = idx[:, None] >= idx[None, :]
    strict = idx[:, None] > idx[None, :]
    diff = G[..., :, None] - G[..., None, :]
    gam_incl = jnp.exp(jnp.where(incl, diff, -jnp.inf))
    gam_strict = jnp.where(strict, gam_incl, 0.0)
    kk = jnp.einsum('bhncd,bhnsd->bhncs', k, k)
    m = beta[..., :, None] * kk * gam_strict
    eye = jnp.eye(c, dtype=jnp.float32)
    t_inv = lax.linalg.triangular_solve(eye + m, jnp.broadcast_to(eye, m.shape),
                                        left_side=True, lower=True, unit_diagonal=True)
    u = jnp.einsum('bhncs,bhnsd->bhncd', t_inv, v * beta[..., None])
    w = jnp.einsum('bhncs,bhnsd->bhncd', t_inv, k * (beta * jnp.exp(G))[..., None])
    a_intra = jnp.einsum('bhncd,bhnsd->bhncs', q, k) * gam_incl
    q_dec = q * jnp.exp(G)[..., None]
    last = G[..., -1]
    k_dec = k * jnp.exp(last[..., None] - G)[..., None]

    def step(s, xs):
        q_n, w_n, u_n, k_n, a_n, last_n = xs
        v_new = u_n - jnp.einsum('bhcd,bhde->bhce', w_n, s)
        o = jnp.einsum('bhcd,bhde->bhce', q_n, s) + jnp.einsum('bhcs,bhse->bhce', a_n, v_new)
        s = s * jnp.exp(last_n)[..., None, None] + jnp.einsum('bhcd,bhce->bhde', k_n, v_new)
        return s, o

    xs = (jnp.moveaxis(q_dec, 2, 0), jnp.moveaxis(w, 2, 0), jnp.moveaxis(u, 2, 0),
          jnp.moveaxis(k_dec, 2, 0), jnp.moveaxis(a_intra, 2, 0), jnp.moveaxis(last, 2, 0))
    s0 = jnp.zeros((b, h, dk, dv), jnp.float32)
    _, o = lax.scan(step, s0, xs)
    return jnp.moveaxis(o, 0, 2).reshape(b, h, t, dv)


def stick_breaking_attention(q, k, v):
    _, _, t, d = q.shape
    scale = 1.0 / math.sqrt(d)
    outs = []
    for i in range(t // SB_BLOCK):
        t0 = i * SB_BLOCK
        kl = t0 + SB_BLOCK
        z = jnp.einsum('bhtd,bhsd->bhts', q[:, :, t0:kl], k[:, :, :kl]).astype(jnp.float32) * scale
        t_pos = t0 + jnp.arange(SB_BLOCK)
        s_pos = jnp.arange(kl)
        causal = s_pos[None, :] < t_pos[:, None]
        log_beta = jax.nn.log_sigmoid(z)
        log_fail = jnp.where(causal, jax.nn.log_sigmoid(-z), 0.0)
        surv = lax.cumsum(log_fail, axis=3, reverse=True) - log_fail
        att = jnp.where(causal, jnp.exp(log_beta + surv), 0.0)
        outs.append(jnp.einsum('bhts,bhsd->bhtd', att.astype(v.dtype), v[:, :, :kl]))
    return jnp.concatenate(outs, axis=2)


def memory_attention(q, mk, mv):
    s = jnp.einsum('bhtd,bhmd->bhtm', q, mk).astype(jnp.float32) * (1.0 / math.sqrt(q.shape[-1]))
    p = jax.nn.softmax(s, axis=-1)
    return jnp.einsum('bhtm,bhmd->bhtd', p.astype(mv.dtype), mv)


def hybrid_layer(x, mem, norm_g, mem_norm_g, w_in, conv_w, a_log, dt_bias, dn_norm_g,
                 w_mem_kv, w_br_dn, w_br_sb, w_br_mem, w_out):
    h = rmsnorm(x, norm_g)
    proj = h @ w_in
    splits = [int(s) for s in np.cumsum(IN_SIZES)[:-1]]
    dn_qkv, dn_z, dn_b, dn_a, sb_qkv, sb_z, m_q, m_z, gates = jnp.split(proj, splits, axis=-1)

    dn_qkv = jax.nn.silu(causal_dwconv(dn_qkv, conv_w))
    dq, dk, dv = jnp.split(dn_qkv, [DN_QK, 2 * DN_QK], axis=-1)
    dq = l2norm(to_heads(dq, DN_HEADS).astype(jnp.float32)) * (DN_DK ** -0.5)
    dk = l2norm(to_heads(dk, DN_HEADS).astype(jnp.float32))
    dv = to_heads(dv, DN_HEADS).astype(jnp.float32)
    beta = jax.nn.sigmoid(dn_b.astype(jnp.float32)).transpose(0, 2, 1)
    g = -(jnp.exp(a_log.astype(jnp.float32))
          * jax.nn.softplus(dn_a.astype(jnp.float32) + dt_bias.astype(jnp.float32))).transpose(0, 2, 1)
    o_dn = gated_delta_rule(dq, dk, dv, beta, g)
    o_dn = merge_heads(rmsnorm(o_dn, dn_norm_g)).astype(x.dtype) * jax.nn.silu(dn_z)

    sq, sk, sv = jnp.split(sb_qkv, 3, axis=-1)
    o_sb = stick_breaking_attention(to_heads(sq, SB_HEADS), to_heads(sk, SB_HEADS), to_heads(sv, SB_HEADS))
    o_sb = merge_heads(o_sb) * jax.nn.silu(sb_z)

    mkv = rmsnorm(mem, mem_norm_g) @ w_mem_kv
    mk, mv = jnp.split(mkv, 2, axis=-1)
    o_m = memory_attention(to_heads(m_q, MEM_HEADS), to_heads(mk, MEM_HEADS), to_heads(mv, MEM_HEADS))
    o_m = merge_heads(o_m) * jax.nn.silu(m_z)

    g_dn, g_sb, g_m = jnp.split(jax.nn.sigmoid(gates), N_BRANCH, axis=-1)
    merged = g_dn * (o_dn @ w_br_dn) + g_sb * (o_sb @ w_br_sb) + g_m * (o_m @ w_br_mem)
    return x + merged @ w_out


def setup_inputs(seed: int = 0) -> dict:
    key = jax.random.key(seed)
    ks = jax.random.split(key, 16)
    f = jnp.float32

    def dense(k, shape, fan_in):
        return jax.random.normal(k, shape, f) * (fan_in ** -0.5)

    def gain(k, shape):
        return 1.0 + 0.02 * jax.random.normal(k, shape, f)

    x = jax.random.normal(ks[0], (BATCH, SEQ, D_MODEL), f)
    mem = jax.random.normal(ks[1], (BATCH, MEM_LEN, D_MODEL), f)
    norm_g = gain(ks[2], (DEPTH, D_MODEL))
    mem_norm_g = gain(ks[3], (DEPTH, D_MODEL))
    w_in = dense(ks[4], (DEPTH, D_MODEL, IN_WIDTH), D_MODEL)
    conv_w = dense(ks[5], (DEPTH, CONV_K, DN_QKV_W), CONV_K)
    a_log = jnp.log(jax.random.uniform(ks[6], (DEPTH, DN_HEADS), f, 1.0, 16.0))
    dt = jnp.exp(jax.random.uniform(ks[7], (DEPTH, DN_HEADS), f, math.log(1e-3), math.log(1e-1)))
    dt_bias = dt + jnp.log(-jnp.expm1(-dt))
    dn_norm_g = gain(ks[8], (DEPTH, DN_DV))
    w_mem_kv = dense(ks[9], (DEPTH, D_MODEL, 2 * MEM_W), D_MODEL)
    w_br_dn = dense(ks[10], (DEPTH, DN_VW, D_MODEL), DN_VW)
    w_br_sb = dense(ks[11], (DEPTH, SB_W, D_MODEL), SB_W)
    w_br_mem = dense(ks[12], (DEPTH, MEM_W, D_MODEL), MEM_W)
    w_out = dense(ks[13], (DEPTH, D_MODEL, D_MODEL), D_MODEL)
    final_g = gain(ks[14], (D_MODEL,))
    return {"x": x, "mem": mem, "norm_g": norm_g, "mem_norm_g": mem_norm_g, "w_in": w_in,
            "conv_w": conv_w, "a_log": a_log, "dt_bias": dt_bias, "dn_norm_g": dn_norm_g,
            "w_mem_kv": w_mem_kv, "w_br_dn": w_br_dn, "w_br_sb": w_br_sb, "w_br_mem": w_br_mem,
            "w_out": w_out, "final_g": final_g}


def reference(x, mem, norm_g, mem_norm_g, w_in, conv_w, a_log, dt_bias, dn_norm_g,
              w_mem_kv, w_br_dn, w_br_sb, w_br_mem, w_out, final_g):
    for l in range(DEPTH):
        x = hybrid_layer(x, mem, norm_g[l], mem_norm_g[l], w_in[l], conv_w[l], a_log[l], dt_bias[l],
                         dn_norm_g[l], w_mem_kv[l], w_br_dn[l], w_br_sb[l], w_br_mem[l], w_out[l])
    return rmsnorm(x, final_g)
```

```cpp
#include <hip/hip_runtime.h>
#include <hip/hip_cooperative_groups.h>
#include <cstdio>
#include <cstdint>
namespace cg = cooperative_groups;
namespace pg8 {
#define PG8_LAS __attribute__((address_space(3)))
typedef unsigned short bf16_t;
typedef short bf16x8 __attribute__((ext_vector_type(8)));
typedef float f32x4 __attribute__((ext_vector_type(4)));
typedef unsigned u32x4 __attribute__((ext_vector_type(4)));
constexpr int BM = 256, BK = 64, HALF = 128, HTB = HALF * BK * 2  , STAGE_BYTES = 8 * HTB, NXCD = 8, WGM = 8;

__host__ __device__ __forceinline__ int lds_byte(int r, int c) { const int st = (r >> 4) * 2 + (c >> 5), rr = r & 15, cc = c & 31, ob = rr * 64 + cc * 2; return st * 1024 + (ob ^ (((ob >> 9) & 1) << 5)); }
__host__ __device__ __forceinline__ void stage_rc(int b, int& R, int& C) { const int st = b / 1024, sb = b % 1024, swz = sb ^ (((sb >> 9) & 1) << 5); R = (st >> 1) * 16 + swz / 64; C = (st & 1) * 32 + (swz % 64) / 2; }
__host__ __device__ __forceinline__ int perm32(int rho) { const int n = rho >> 4, i = rho & 15; return 8 * (i >> 2) + 4 * n + (i & 3); }

struct Unit { int pm, pn; };
struct Gemm { const bf16_t* A; const bf16_t* Bt; int M, N, K; };

struct StaticOrder {
    int nM, nN, nwg, G, c;
    __host__ __device__ void init(int M, int N, int G_, int c_) { nM = M / BM; nN = N / BM; nwg = nM * nN; G = G_; c = c_; }
    __host__ __device__ bool next(int i, Unit& u) const {
        const long L = (long)i * G + c; if (L >= nwg) return false;
        int wgid = (int)L; { const int q = nwg / NXCD, r = nwg % NXCD, xcd = wgid % NXCD, off = wgid / NXCD; wgid = (xcd < r ? xcd * (q + 1) : r * (q + 1) + (xcd - r) * q) + off; }
        const int nig = WGM * nN, gid = wgid / nig, fm = gid * WGM, gsz = (nM - fm) < WGM ? (nM - fm) : WGM;
        u.pm = fm + ((wgid % nig) % gsz); u.pn = (wgid % nig) / gsz; return true;
    }
    __device__ __forceinline__ void a_ready(const Unit&) const {}
    __device__ __forceinline__ void done(const Unit&) const {}
};

__device__ __forceinline__ unsigned cvt_pk_bf16(float lo, float hi) { unsigned r; asm volatile("v_cvt_pk_bf16_f32 %0, %1, %2" : "=v"(r) : "v"(lo), "v"(hi)); return r; }
template <class Epi, class Sched, bool ALIGN_EPI = false, bool SP2 = false>
__device__ __forceinline__ void gemm_phase(PG8_LAS unsigned char* lds, const Gemm g, const Sched& S, const Epi& E, const int wid  ) {
    const int lane = (int)__builtin_amdgcn_mbcnt_hi(~0u, __builtin_amdgcn_mbcnt_lo(~0u, 0u)), tid = wid * 64 + lane, wr = wid >> 2, wc = wid & 3, fr = lane & 15, fq = lane >> 4;
    const int K = g.K, nt = K / BK;
    unsigned voffA[2], voffB[2];
#pragma unroll
    for (int i = 0; i < 2; ++i) { int R, C; stage_rc(tid * 16 + i * 8192, R, C); const int Rb = Epi::PERM ? ((R & ~31) + perm32(R & 31)) : R;
        voffA[i] = (unsigned)(R * K + C) * 2u; voffB[i] = (unsigned)(Rb * K + C) * 2u; }
    const size_t kstep = (size_t)(BK * 2);
    const size_t hstep = (size_t)HALF * K * 2;
    const size_t tstep = 2 * hstep;
    const unsigned ldsw = (unsigned)wid * 1024u;
    const int aoff = lds_byte(wr * 64 + fr, fq * 8), boff = lds_byte(wc * 32 + fr, fq * 8);
#define PG8_SA(b, h) (((b) * 2 + (h)) * HTB)
#define PG8_SB(b, h) ((4 + (b) * 2 + (h)) * HTB)
#define PG8_STAGE(bufoff, gbase, voff) do { _Pragma("unroll") for (int _i = 0; _i < 2; ++_i) \
        __builtin_amdgcn_global_load_lds((const unsigned*)((const char*)(gbase) + (voff)[_i]), (PG8_LAS unsigned*)(lds + (bufoff) + ldsw + _i * 8192), 16, 0, 0); } while (0)
#define PG8_LDA(dst, b, h) do { _Pragma("unroll") for (int m = 0; m < 4; ++m) _Pragma("unroll") for (int k = 0; k < 2; ++k) dst[m][k] = *(const PG8_LAS bf16x8*)(lds + PG8_SA(b, h) + aoff + m * 2048 + k * 1024); } while (0)
#define PG8_LDB(dst, b, h) do { _Pragma("unroll") for (int n = 0; n < 2; ++n) _Pragma("unroll") for (int k = 0; k < 2; ++k) dst[n][k] = *(const PG8_LAS bf16x8*)(lds + PG8_SB(b, h) + boff + n * 2048 + k * 1024); } while (0)
#define PG8_MMA(ai, bj, At, Bt) do { __builtin_amdgcn_s_setprio(1); _Pragma("unroll") for (int m = 0; m < 4; ++m) _Pragma("unroll") for (int n = 0; n < 2; ++n) _Pragma("unroll") for (int k = 0; k < 2; ++k) \
        acc[ai][bj][m][n] = __builtin_amdgcn_mfma_f32_16x16x32_bf16(Bt[n][k], At[m][k], acc[ai][bj][m][n], 0, 0, 0); __builtin_amdgcn_s_setprio(0); } while (0)
#define PG8_WAIT_V(n) asm volatile("s_waitcnt vmcnt(" #n ")" ::: "memory")
#define PG8_WAIT_L(n) asm volatile("s_waitcnt lgkmcnt(" #n ")" ::: "memory")
#define PG8_BAR __builtin_amdgcn_s_barrier()
#define PG8_SCHED __builtin_amdgcn_sched_barrier(0)
    Unit cur, nxt; int ui = 0;
    if (!S.next(0, cur)) return;
    f32x4 acc[2][2][4][2];
#pragma unroll
    for (int a = 0; a < 2; ++a)
#pragma unroll
        for (int b = 0; b < 2; ++b)
#pragma unroll
            for (int m = 0; m < 4; ++m)
#pragma unroll
                for (int n = 0; n < 2; ++n) acc[a][b][m][n] = (f32x4){0.f, 0.f, 0.f, 0.f};
    bf16x8 At[4][2], B0[2][2], B1[2][2];
    const char* cA = (const char*)g.A + (size_t)cur.pm * tstep; const char* cB = (const char*)g.Bt + (size_t)cur.pn * tstep;
    S.a_ready(cur);
    if constexpr (SP2) {
        PG8_STAGE(PG8_SB(0, 0), cB, voffB); PG8_STAGE(PG8_SB(0, 1), cB + hstep, voffB); PG8_STAGE(PG8_SA(0, 0), cA, voffA); PG8_STAGE(PG8_SA(0, 1), cA + hstep, voffA);
        if (wr == 1) PG8_BAR;
        PG8_WAIT_V(2); PG8_BAR;
        PG8_STAGE(PG8_SB(1, 0), cB + kstep, voffB); PG8_STAGE(PG8_SA(1, 0), cA + kstep, voffA); PG8_STAGE(PG8_SB(1, 1), cB + hstep + kstep, voffB);
        PG8_WAIT_V(6); PG8_BAR;
    } else {
        PG8_STAGE(PG8_SB(0, 0), cB, voffB); PG8_STAGE(PG8_SA(0, 0), cA, voffA); PG8_STAGE(PG8_SB(0, 1), cB + hstep, voffB); PG8_STAGE(PG8_SA(0, 1), cA + hstep, voffA);
        if (wr == 1) PG8_BAR;
        PG8_WAIT_V(4); PG8_BAR;
        PG8_STAGE(PG8_SB(1, 0), cB + kstep, voffB); PG8_STAGE(PG8_SA(1, 0), cA + kstep, voffA); PG8_STAGE(PG8_SB(1, 1), cB + hstep + kstep, voffB);
        PG8_WAIT_V(6); PG8_BAR;
    }
    for (;;) {
        const bool has_next = S.next(ui + 1, nxt);
        const char* nA = has_next ? (const char*)g.A + (size_t)nxt.pm * tstep : cA; const char* nB = has_next ? (const char*)g.Bt + (size_t)nxt.pn * tstep : cB;
        for (int t = 0; t < nt; t += 2) {
            const bool last = (t == nt - 2);
            const char* a1 = cA + (size_t)(t + 1) * kstep;
            const char* a2 = last ? nA : cA + (size_t)(t + 2) * kstep; const char* b2 = last ? nB : cB + (size_t)(t + 2) * kstep;
            const char* a3 = a2 + kstep; const char* b3 = b2 + kstep;
            if (last && has_next) S.a_ready(nxt);
            if constexpr (SP2) {
            PG8_LDB(B0, 0, 0); PG8_LDB(B1, 0, 1); PG8_SCHED; PG8_LDA(At, 0, 0); PG8_STAGE(PG8_SA(1, 1), a1 + hstep, voffA);
            PG8_WAIT_V(8); PG8_WAIT_L(0); PG8_BAR; PG8_MMA(0, 0, At, B0); PG8_MMA(0, 1, At, B1); PG8_BAR; PG8_SCHED;
            PG8_LDA(At, 0, 1); PG8_STAGE(PG8_SB(0, 0), b2, voffB); PG8_STAGE(PG8_SB(0, 1), b2 + hstep, voffB); PG8_STAGE(PG8_SA(0, 0), a2, voffA);
            PG8_WAIT_V(8); PG8_WAIT_L(0); PG8_BAR; PG8_MMA(1, 0, At, B0); PG8_MMA(1, 1, At, B1); PG8_BAR; PG8_SCHED;
            PG8_LDB(B0, 1, 0); PG8_LDB(B1, 1, 1); PG8_SCHED; PG8_LDA(At, 1, 0); PG8_STAGE(PG8_SA(0, 1), a2 + hstep, voffA);
            PG8_WAIT_V(8); PG8_WAIT_L(0); PG8_BAR; PG8_MMA(0, 0, At, B0); PG8_MMA(0, 1, At, B1); PG8_BAR; PG8_SCHED;
            PG8_LDA(At, 1, 1); PG8_STAGE(PG8_SB(1, 0), b3, voffB); PG8_STAGE(PG8_SB(1, 1), b3 + hstep, voffB); PG8_STAGE(PG8_SA(1, 0), a3, voffA);
            PG8_WAIT_V(8); PG8_WAIT_L(0); PG8_BAR; PG8_MMA(1, 0, At, B0); PG8_MMA(1, 1, At, B1); PG8_BAR; PG8_SCHED;
            } else {
            PG8_LDB(B0, 0, 0); PG8_SCHED; PG8_LDA(At, 0, 0); PG8_STAGE(PG8_SA(1, 1), a1 + hstep, voffA);
            PG8_WAIT_L(8); PG8_BAR; PG8_WAIT_L(0); PG8_MMA(0, 0, At, B0); PG8_BAR; PG8_SCHED;
            PG8_LDB(B1, 0, 1); PG8_STAGE(PG8_SB(0, 0), b2, voffB);
            PG8_BAR; PG8_WAIT_L(0); PG8_MMA(0, 1, At, B1); PG8_BAR;
            PG8_LDA(At, 0, 1); PG8_STAGE(PG8_SA(0, 0), a2, voffA);
            PG8_BAR; PG8_WAIT_L(0); PG8_MMA(1, 0, At, B0); PG8_BAR; PG8_SCHED;
            PG8_STAGE(PG8_SB(0, 1), b2 + hstep, voffB);
            PG8_WAIT_V(6); PG8_BAR; PG8_MMA(1, 1, At, B1); PG8_BAR;
            PG8_LDB(B0, 1, 0); PG8_SCHED; PG8_LDA(At, 1, 0); PG8_STAGE(PG8_SA(0, 1), a2 + hstep, voffA);
            PG8_WAIT_L(8); PG8_BAR; PG8_WAIT_L(0); PG8_MMA(0, 0, At, B0); PG8_BAR; PG8_SCHED;
            PG8_LDB(B1, 1, 1); PG8_STAGE(PG8_SB(1, 0), b3, voffB);
            PG8_BAR; PG8_WAIT_L(0); PG8_MMA(0, 1, At, B1); PG8_BAR;
            PG8_LDA(At, 1, 1); PG8_STAGE(PG8_SA(1, 0), a3, voffA);
            PG8_BAR; PG8_WAIT_L(0); PG8_MMA(1, 0, At, B0); PG8_BAR; PG8_SCHED;
            PG8_STAGE(PG8_SB(1, 1), b3 + hstep, voffB);
            PG8_WAIT_V(6); PG8_BAR; PG8_MMA(1, 1, At, B1); PG8_BAR;
            }
        }
        if constexpr (ALIGN_EPI) { if (wr == 0) PG8_BAR; }
        if constexpr (!Epi::AFTER_DRAIN) { E(acc, cur, wr, wc, fr, fq); S.done(cur); }
        if (!has_next) break;
#pragma unroll
        for (int a = 0; a < 2; ++a)
#pragma unroll
            for (int b = 0; b < 2; ++b)
#pragma unroll
                for (int m = 0; m < 4; ++m)
#pragma unroll
                    for (int n = 0; n < 2; ++n) acc[a][b][m][n] = (f32x4){0.f, 0.f, 0.f, 0.f};
        cur = nxt; cA = nA; cB = nB; ++ui;
        if constexpr (ALIGN_EPI) { if (wr == 1) PG8_BAR; }
    }
    PG8_WAIT_V(0);
    if constexpr (!ALIGN_EPI) { if (wr == 0) PG8_BAR; }
    PG8_BAR;
    if constexpr (Epi::AFTER_DRAIN) { E.fused(acc, cur, wr, wc, fr, fq, lds, wid, lane); S.done(cur); }
#undef PG8_SA
#undef PG8_SB
#undef PG8_STAGE
#undef PG8_LDA
#undef PG8_LDB
#undef PG8_MMA
#undef PG8_WAIT_V
#undef PG8_WAIT_L
#undef PG8_BAR
#undef PG8_SCHED
}
}
namespace pg8 {
__device__ __forceinline__ unsigned short bf_rne(float f) { unsigned u = __builtin_bit_cast(unsigned, f); return (unsigned short)((u + 0x7fffu + ((u >> 16) & 1u)) >> 16); }
__device__ __forceinline__ u32x4 pack8(const f32x4& v0, const f32x4& v1) { u32x4 w; w.x = cvt_pk_bf16(v0[0], v0[1]); w.y = cvt_pk_bf16(v0[2], v0[3]); w.z = cvt_pk_bf16(v1[0], v1[1]); w.w = cvt_pk_bf16(v1[2], v1[3]); return w; }
__device__ __forceinline__ void store_tile_bf16(const f32x4 (&acc)[2][2][4][2], const Unit& u, int wr, int wc, int fr, int fq, bf16_t* base, int ld, int col0, bool tr, int hd, int nh, int srows, bf16_t* halo, int halo_col0) {
    const int row0 = u.pm * BM + wr * 64 + fr, cl0 = wc * 32 + 8 * fq;
#pragma unroll
    for (int ai = 0; ai < 2; ++ai)
#pragma unroll
        for (int m = 0; m < 4; ++m) { const int row = row0 + ai * HALF + m * 16;
#pragma unroll
            for (int bj = 0; bj < 2; ++bj) { const f32x4 v0 = acc[ai][bj][m][0], v1 = acc[ai][bj][m][1]; const int c = col0 + cl0 + bj * HALF;
                { const u32x4 w = pack8(v0, v1); *(u32x4*)(base + (size_t)row * ld + c) = w;
                    if (halo && (row & 63) >= 61) *(u32x4*)(halo + (size_t)((row >> 6) * 3 + (row & 63) - 61) * 3072 + halo_col0 + cl0 + bj * HALF) = w;
                } } }
}
struct EpiG1 {
    static constexpr bool PERM = true, AFTER_DRAIN = false;
    bf16_t *Q, *K, *VT, *Z, *MQ, *MZ;
    __device__ __forceinline__ void operator()(const f32x4 (&acc)[2][2][4][2], const Unit& u, int wr, int wc, int fr, int fq) const {
        const int kind = u.pn >> 2, sub = u.pn & 3;
        if (kind == 4) { store_tile_bf16(acc, u, wr, wc, fr, fq, sub == 0 ? MQ : MZ, 256, 0, false, 0, 0, 0, nullptr, 0); return; }
        bf16_t* base = kind == 0 ? Q : (kind == 1 ? K : (kind == 2 ? VT : Z));
        store_tile_bf16(acc, u, wr, wc, fr, fq, base, 1024, sub * 256, false, 0, 0, 0, nullptr, 0);
    }
};
struct EpiMKV {
    static constexpr bool PERM = true, AFTER_DRAIN = false;
    bf16_t *MKV;
    __device__ __forceinline__ void operator()(const f32x4 (&acc)[2][2][4][2], const Unit& u, int wr, int wc, int fr, int fq) const {
        store_tile_bf16(acc, u, wr, wc, fr, fq, MKV, 512, u.pn * 256, false, 0, 0, 0, nullptr, 0);
    }
};
struct EpiG3 {
    static constexpr bool PERM = true, AFTER_DRAIN = false;
    bf16_t *Q, *K, *V, *Z, *HALO;
    __device__ __forceinline__ void operator()(const f32x4 (&acc)[2][2][4][2], const Unit& u, int wr, int wc, int fr, int fq) const {
        const int kind = u.pn >> 2, sub = u.pn & 3;
        bf16_t* base = kind == 0 ? Q : (kind == 1 ? K : (kind == 2 ? V : Z));
        store_tile_bf16(acc, u, wr, wc, fr, fq, base, 1024, sub * 256, false, 0, 0, 0, kind < 3 ? HALO : nullptr, u.pn * 256);
    }
};
struct EpiGate {
    static constexpr bool PERM = true, AFTER_DRAIN = false;
    bf16_t* Gs; int ldc;
    __device__ __forceinline__ void operator()(const f32x4 (&acc)[2][2][4][2], const Unit& u, int wr, int wc, int fr, int fq) const {
        const int row0 = u.pm * BM + wr * 64 + fr, col0 = u.pn * BM + wc * 32 + 8 * fq;
#pragma unroll
        for (int ai = 0; ai < 2; ++ai)
#pragma unroll
            for (int m = 0; m < 4; ++m)
#pragma unroll
                for (int bj = 0; bj < 2; ++bj) { f32x4 v0 = acc[ai][bj][m][0], v1 = acc[ai][bj][m][1];
#pragma unroll
                    for (int e = 0; e < 4; ++e) { v0[e] = 1.0f / (1.0f + __expf(-v0[e])); v1[e] = 1.0f / (1.0f + __expf(-v1[e])); }
                    *(u32x4*)(Gs + (size_t)(row0 + ai * HALF + m * 16) * ldc + col0 + bj * HALF) = pack8(v0, v1); }
    }
};
template <int MODE> struct EpiMerge {
    static constexpr bool PERM = true, AFTER_DRAIN = false;
    const bf16_t* Gs; float* Ms; bf16_t* Out; int ldc;
    __device__ __forceinline__ void operator()(const f32x4 (&acc)[2][2][4][2], const Unit& u, int wr, int wc, int fr, int fq) const {
        const int row0 = u.pm * BM + wr * 64 + fr, col0 = u.pn * BM + wc * 32 + 8 * fq;
#pragma unroll
        for (int ai = 0; ai < 2; ++ai)
#pragma unroll
            for (int m = 0; m < 4; ++m)
#pragma unroll
                for (int bj = 0; bj < 2; ++bj) { const size_t off = (size_t)(row0 + ai * HALF + m * 16) * ldc + col0 + bj * HALF;
                    const u32x4 g = *(const u32x4*)(Gs + off); f32x4 v0 = acc[ai][bj][m][0], v1 = acc[ai][bj][m][1];
                    f32x4 g0, g1; g0[0] = __builtin_bit_cast(float, g.x << 16); g0[1] = __builtin_bit_cast(float, g.x & 0xffff0000u); g0[2] = __builtin_bit_cast(float, g.y << 16); g0[3] = __builtin_bit_cast(float, g.y & 0xffff0000u);
                    g1[0] = __builtin_bit_cast(float, g.z << 16); g1[1] = __builtin_bit_cast(float, g.z & 0xffff0000u); g1[2] = __builtin_bit_cast(float, g.w << 16); g1[3] = __builtin_bit_cast(float, g.w & 0xffff0000u);
                    v0 = v0 * g0; v1 = v1 * g1;
                    if (MODE == 1 || MODE == 2) { v0 += *(const f32x4*)(Ms + off); v1 += *(const f32x4*)(Ms + off + 4); }
                    if (MODE == 0 || MODE == 1) { *(f32x4*)(Ms + off) = v0; *(f32x4*)(Ms + off + 4) = v1; }
                    else *(u32x4*)(Out + off) = pack8(v0, v1); }
    }
};
struct EpiResid {
    static constexpr bool PERM = false, AFTER_DRAIN = false;
    const float* X; float* Y; int ldc;
    __device__ __forceinline__ void operator()(const f32x4 (&acc)[2][2][4][2], const Unit& u, int wr, int wc, int fr, int fq) const {
        const int row0 = u.pm * BM + wr * 64 + fr, col0 = u.pn * BM + wc * 32 + 4 * fq;
#pragma unroll
        for (int ai = 0; ai < 2; ++ai)
#pragma unroll
            for (int m = 0; m < 4; ++m) { const size_t ro = (size_t)(row0 + ai * HALF + m * 16) * ldc + col0;
#pragma unroll
                for (int bj = 0; bj < 2; ++bj)
#pragma unroll
                    for (int n = 0; n < 2; ++n) { const size_t off = ro + bj * HALF + n * 16; *(f32x4*)(Y + off) = acc[ai][bj][m][n] + *(const f32x4*)(X + off); } }
    }
};
}

#ifndef MK_N_LAUNCHES
#define MK_N_LAUNCHES 0
#endif
constexpr int NWAVES = 8, NTHR = NWAVES * 64;
constexpr int BATCH = 8, SEQ = 2048, DM = 1024, M = BATCH * SEQ;
constexpr int MEM_LEN = 256, MROWS = BATCH * MEM_LEN;
constexpr int IN_WIDTH = 11792;
constexpr int C_DNQKV = 0, C_DNZ = 3072, C_DNB = 4096, C_DNA = 4104, C_SBQKV = 4112, C_SBZ = 7184, C_MQ = 8208, C_MZ = 8464, C_GATE = 8720;
constexpr int N1 = 4608, N3 = 4096, NG = 3072;
constexpr float NORM_EPS = 1e-6f;
constexpr int NHEAD = 8, DH = 128, CH = 64, NCH = SEQ / CH;
constexpr int MH = 4, MDH = 64;

constexpr size_t MiB = 1u << 20;
constexpr size_t WS_CTL = 0, CTL_ZERO_BYTES = 1 * MiB;
constexpr size_t WS_W1T = 1 * MiB, WS_W3T = 10 * MiB, WS_WGT = 18 * MiB, WS_WMKVT = 24 * MiB, WS_WBDN = 25 * MiB, WS_WBSB = 27 * MiB, WS_WBM = 29 * MiB, WS_WOUT = 30 * MiB;
constexpr size_t WS_HN = 32 * MiB;
constexpr size_t WS_R1 = 64 * MiB, WS_R2 = 96 * MiB, WS_R3 = 128 * MiB, WS_R4 = 160 * MiB, WS_R5 = 192 * MiB;
constexpr size_t WS_BG = 224 * MiB, WS_MEMN = 225 * MiB, WS_MK = 229 * MiB  , WS_HALO = 231 * MiB, WS_DECAY = 236 * MiB, WS_END = 237 * MiB;
constexpr size_t OUT_SBQ = 0, OUT_MQ = 32 * MiB, OUT_MZ = 40 * MiB, OUT_A = 48 * MiB;

constexpr int LDS_BYTES = 147456;
#define LAS __attribute__((address_space(3)))
#define GAS __attribute__((address_space(1)))
typedef unsigned short bf16;
typedef float f32x4 __attribute__((ext_vector_type(4)));
typedef float f32x16 __attribute__((ext_vector_type(16)));
typedef short bf16x8 __attribute__((ext_vector_type(8)));
typedef short s16x4 __attribute__((ext_vector_type(4)));
typedef unsigned u32x4 __attribute__((ext_vector_type(4)));
typedef unsigned u32x2 __attribute__((ext_vector_type(2)));

__device__ __forceinline__ unsigned f2bf(float f) { unsigned u = __builtin_bit_cast(unsigned, f); return (u + 0x7fffu + ((u >> 16) & 1u)) >> 16; }
__device__ __forceinline__ unsigned pk2(float lo, float hi) { return f2bf(lo) | (f2bf(hi) << 16); }
__device__ __forceinline__ float bf2f(unsigned short b) { return __builtin_bit_cast(float, (unsigned)b << 16); }
__device__ __forceinline__ float wave_sum(float v) {
#pragma unroll
    for (int o = 1; o < 64; o <<= 1) v += __shfl_xor(v, o);
    return v;
}
__device__ __forceinline__ int lane_id() { return (int)__builtin_amdgcn_mbcnt_hi(~0u, __builtin_amdgcn_mbcnt_lo(~0u, 0u)); }
__device__ __forceinline__ float sigmoidf_(float x) { return 1.0f / (1.0f + __expf(-x)); }
__device__ __forceinline__ float siluf_(float x) { return x / (1.0f + __expf(-x)); }

struct Args { const float* in[15]; float* out; unsigned char* ws; int ph_lo, ph_hi; };
enum { I_X = 0, I_MEM, I_NORMG, I_MEMNORMG, I_WIN, I_CONVW, I_ALOG, I_DTBIAS, I_DNNORMG, I_WMEMKV, I_WBRDN, I_WBRSB, I_WBRMEM, I_WOUT, I_FINALG };
enum { PH_PRO = 0, PH_GEMM1, PH_ATTN, PH_GEMM3, PH_PREP, PH_SCAN, PH_MERGE, PH_OUT, PH_NORM, PH_COUNT };

__device__ __forceinline__ void p0_transpose_item(const float* W, int ldw, int K, int N, bf16* WT, LAS float* scr, int item, int lane) {
    const int nblk = N / 32, kb = item / nblk, nb = item % nblk, k0 = 64 * kb, n0 = 32 * nb;
#pragma unroll 8
    for (int i = 0; i < 32; ++i) { const int kk = 2 * i + (lane >> 5); scr[kk * 33 + (lane & 31)] = W[(size_t)(k0 + kk) * ldw + n0 + (lane & 31)]; }
    asm volatile("s_waitcnt lgkmcnt(0)" ::: "memory");
    const int c = lane & 7;
#pragma unroll
    for (int j = 0; j < 4; ++j) { const int n = (lane >> 3) + 8 * j; const LAS float* s = scr + (8 * c) * 33 + n;
        u32x4 o; o.x = pk2(s[0 * 33], s[1 * 33]); o.y = pk2(s[2 * 33], s[3 * 33]); o.z = pk2(s[4 * 33], s[5 * 33]); o.w = pk2(s[6 * 33], s[7 * 33]);
        *(u32x4*)(WT + (size_t)(n0 + n) * K + k0 + 8 * c) = o; }
    asm volatile("s_waitcnt lgkmcnt(0)" ::: "memory");
}
__device__ __forceinline__ void rms_row(const float* xrow, const float* g, int lane, f32x4 (&v)[4]) {
    const f32x4* xr = (const f32x4*)xrow + lane; const f32x4* gr = (const f32x4*)g + lane;
    float s = 0.f;
#pragma unroll
    for (int j = 0; j < 4; ++j) { v[j] = xr[64 * j]; s += (v[j].x * v[j].x + v[j].y * v[j].y) + (v[j].z * v[j].z + v[j].w * v[j].w); }
    const float rs = 1.0f / sqrtf(wave_sum(s) * (1.0f / DM) + NORM_EPS);
#pragma unroll
    for (int j = 0; j < 4; ++j) { const f32x4 gg = gr[64 * j]; v[j] = v[j] * rs * gg; }
}
__device__ __forceinline__ void store_row_bf16(bf16* orow, int lane, const f32x4 (&v)[4]) {
    unsigned long long* o8 = (unsigned long long*)orow + lane;
#pragma unroll
    for (int j = 0; j < 4; ++j) o8[64 * j] = (unsigned long long)pk2(v[j].x, v[j].y) | ((unsigned long long)pk2(v[j].z, v[j].w) << 32);
}
__device__ __forceinline__ void p0_prologue(const Args& a, LAS unsigned char* lds, int vcu, int G, int wave, int lane) {
    unsigned char* ws = a.ws;
    const int gw = vcu * NWAVES + wave, NGW = G * NWAVES;
    {
        LAS float* scr = (LAS float*)(lds + wave * 16384);
        const float* win = a.in[I_WIN];
        const int it1 = 16 * (N1 / 32), it3 = 16 * (N3 / 32), itg = 16 * (NG / 32), itkv = 16 * (512 / 32), itb = 16 * (1024 / 32), itm = 4 * (1024 / 32);
        const int total = it1 + it3 + itg + itkv + 3 * itb + itm;
        for (int it = gw; it < total; it += NGW) {
            int r = it;
            if (r < it1) { p0_transpose_item(win + C_SBQKV, IN_WIDTH, 1024, N1, (bf16*)(ws + WS_W1T), scr, r, lane); continue; } r -= it1;
            if (r < it3) { p0_transpose_item(win + C_DNQKV, IN_WIDTH, 1024, N3, (bf16*)(ws + WS_W3T), scr, r, lane); continue; } r -= it3;
            if (r < itg) { p0_transpose_item(win + C_GATE, IN_WIDTH, 1024, NG, (bf16*)(ws + WS_WGT), scr, r, lane); continue; } r -= itg;
            if (r < itkv) { p0_transpose_item(a.in[I_WMEMKV], 512, 1024, 512, (bf16*)(ws + WS_WMKVT), scr, r, lane); continue; } r -= itkv;
            if (r < itb) { p0_transpose_item(a.in[I_WBRDN], 1024, 1024, 1024, (bf16*)(ws + WS_WBDN), scr, r, lane); continue; } r -= itb;
            if (r < itb) { p0_transpose_item(a.in[I_WBRSB], 1024, 1024, 1024, (bf16*)(ws + WS_WBSB), scr, r, lane); continue; } r -= itb;
            if (r < itb) { p0_transpose_item(a.in[I_WOUT], 1024, 1024, 1024, (bf16*)(ws + WS_WOUT), scr, r, lane); continue; } r -= itb;
            p0_transpose_item(a.in[I_WBRMEM], 1024, 256, 1024, (bf16*)(ws + WS_WBM), scr, r, lane);
        }
    }
    __syncthreads();
    {
        LAS float* wbgT = (LAS float*)lds;
        const float* wsrc = a.in[I_WIN] + C_DNB;
        for (int i = wave * 64 + lane; i < 1024 * 16; i += NTHR) { const int k = i >> 4, c = i & 15; wbgT[c * 1028 + k] = wsrc[(size_t)k * IN_WIDTH + c]; }
    }
    __syncthreads();
    {
        LAS float* wbgT = (LAS float*)lds;
        LAS float* hrow = (LAS float*)(lds + 16 * 1028 * 4 + wave * 4096);
        bf16* HN = (bf16*)(ws + WS_HN); float* BG = (float*)(ws + WS_BG);
        const int c = lane & 15, kq = lane >> 4;
        for (int m = gw; m < M; m += NGW) {
            f32x4 v[4]; rms_row(a.in[I_X] + (size_t)m * DM, a.in[I_NORMG], lane, v);
            store_row_bf16(HN + (size_t)m * DM, lane, v);
#pragma unroll
            for (int j = 0; j < 4; ++j) *(LAS f32x4*)(hrow + 256 * j + 4 * lane) = v[j];
            asm volatile("s_waitcnt lgkmcnt(0)" ::: "memory");
            float acc = 0.f;
#pragma unroll 8
            for (int t = 0; t < 64; ++t) { const f32x4 w = *(const LAS f32x4*)(wbgT + c * 1028 + 256 * kq + 4 * t); const f32x4 h = *(const LAS f32x4*)(hrow + 256 * kq + 4 * t);
                acc += (w.x * h.x + w.y * h.y) + (w.z * h.z + w.w * h.w); }
            acc += __shfl_xor(acc, 16); acc += __shfl_xor(acc, 32);
            if (lane < 16) BG[(size_t)m * 16 + lane] = acc;
            asm volatile("s_waitcnt lgkmcnt(0)" ::: "memory");
        }
        bf16* MEMN = (bf16*)(ws + WS_MEMN);
        for (int m = gw; m < MROWS; m += NGW) { f32x4 v[4]; rms_row(a.in[I_MEM] + (size_t)m * DM, a.in[I_MEMNORMG], lane, v); store_row_bf16(MEMN + (size_t)m * DM, lane, v); }
    }
}
__device__ __forceinline__ void p8_final_norm(const Args& a, const float* src, int vcu, int G, int wave, int lane) {
    const int gw = vcu * NWAVES + wave, NGW = G * NWAVES;
    for (int m = gw; m < M; m += NGW) { f32x4 v[4]; rms_row(src + (size_t)m * DM, a.in[I_FINALG], lane, v);
        f32x4* o = (f32x4*)(a.out + (size_t)m * DM) + lane;
#pragma unroll
        for (int j = 0; j < 4; ++j) o[64 * j] = v[j]; }
}
#define MFMA32(a, b, c) __builtin_amdgcn_mfma_f32_32x32x16_bf16((a), (b), (c), 0, 0, 0)
__device__ __forceinline__ int crow(int r, int h) { return (r & 3) + 8 * (r >> 2) + 4 * h; }
__device__ __forceinline__ bf16x8 ldsfrag(const LAS bf16* p) { return *(const LAS bf16x8*)p; }
__device__ __forceinline__ f32x16 zero16() { f32x16 z;
#pragma unroll
    for (int i = 0; i < 16; ++i) z[i] = 0.f; return z; }
#define LDS_WAIT() asm volatile("s_waitcnt lgkmcnt(0)" ::: "memory")

__device__ __forceinline__ void mem_attn_unit(const Args& a, LAS unsigned char* lds, int u, int wave, int lane) {
    const int b = u >> 5, hm = (u >> 3) & 3, tb = u & 7, tid = wave * 64 + lane;
    const bf16* MKV = (const bf16*)(a.ws + WS_MK);
    bf16* MQ = (bf16*)((unsigned char*)a.out + OUT_MQ); const bf16* MZ = (const bf16*)((unsigned char*)a.out + OUT_MZ);
    LAS bf16* MKs = (LAS bf16*)lds;
    LAS bf16* MVTs = (LAS bf16*)(lds + 36864);
    LAS bf16* Pw = (LAS bf16*)(lds + 36864 + 33792 + wave * 4608);
    __syncthreads();
    for (int i = tid; i < 2048; i += NTHR) { const int r = i >> 3, c = i & 7; *(LAS u32x4*)(MKs + r * 72 + c * 8) = *(const u32x4*)(MKV + (size_t)(b * 256 + r) * 512 + hm * 64 + c * 8); }
    for (int i = tid; i < 2048; i += NTHR) { const int m = i & 255, c = i >> 8; const u32x4 v = *(const u32x4*)(MKV + (size_t)(b * 256 + m) * 512 + 256 + hm * 64 + c * 8);
        const unsigned w4[4] = {v.x, v.y, v.z, v.w};
#pragma unroll
        for (int e = 0; e < 8; ++e) MVTs[(c * 8 + e) * 264 + m] = (bf16)(w4[e >> 1] >> ((e & 1) * 16)); }
    __syncthreads();
    const int r32 = lane & 31, hh = lane >> 5;
    const size_t row0 = (size_t)b * SEQ + tb * 256 + wave * 32;
    bf16x8 qf[4];
#pragma unroll
    for (int ks = 0; ks < 4; ++ks) qf[ks] = *(const bf16x8*)(MQ + (row0 + r32) * 256 + hm * 64 + 16 * ks + 8 * hh);
    f32x16 p[8];
#pragma unroll
    for (int mt = 0; mt < 8; ++mt) { p[mt] = zero16();
#pragma unroll
        for (int ks = 0; ks < 4; ++ks) p[mt] = MFMA32(ldsfrag(MKs + (32 * mt + r32) * 72 + 16 * ks + 8 * hh), qf[ks], p[mt]); }
    float mx = -3.0e38f;
#pragma unroll
    for (int mt = 0; mt < 8; ++mt)
#pragma unroll
        for (int r = 0; r < 16; ++r) mx = fmaxf(mx, p[mt][r]);
    mx = fmaxf(mx, __shfl_xor(mx, 32));
    float sum = 0.f;
#pragma unroll
    for (int mt = 0; mt < 8; ++mt)
#pragma unroll
        for (int r = 0; r < 16; ++r) { const float e = __expf((p[mt][r] - mx) * 0.125f); p[mt][r] = e; sum += e; }
    sum += __shfl_xor(sum, 32);
    const float inv = 1.0f / sum;
    f32x16 o[2]; o[0] = zero16(); o[1] = zero16();
#pragma unroll
    for (int c = 0; c < 4; ++c) {
#pragma unroll
        for (int k2 = 0; k2 < 2; ++k2)
#pragma unroll
            for (int g = 0; g < 4; ++g) { const f32x16& pp = p[2 * c + k2]; u32x2 w; w.x = pk2(pp[4 * g] * inv, pp[4 * g + 1] * inv); w.y = pk2(pp[4 * g + 2] * inv, pp[4 * g + 3] * inv);
                *(LAS u32x2*)(Pw + r32 * 72 + 32 * k2 + 8 * g + 4 * hh) = w; }
        LDS_WAIT();
#pragma unroll
        for (int ks = 0; ks < 4; ++ks) { const bf16x8 pa = ldsfrag(Pw + r32 * 72 + 16 * ks + 8 * hh);
#pragma unroll
            for (int dt = 0; dt < 2; ++dt) o[dt] = MFMA32(pa, ldsfrag(MVTs + (32 * dt + r32) * 264 + 64 * c + 16 * ks + 8 * hh), o[dt]); }
        LDS_WAIT();
    }
#pragma unroll
    for (int dt = 0; dt < 2; ++dt)
#pragma unroll
        for (int r = 0; r < 16; ++r) { const size_t off = (row0 + crow(r, hh)) * 256 + hm * 64 + 32 * dt + r32; MQ[off] = (bf16)f2bf(o[dt][r] * siluf_(bf2f(MZ[off]))); }
}

__device__ __forceinline__ void sb_attn_unit(const Args& a, LAS unsigned char* lds, int b, int h, int qb, int wave, int lane) {
    const bf16* K = (const bf16*)(a.ws + WS_R1); const bf16* V = (const bf16*)(a.ws + WS_R2); const bf16* Z = (const bf16*)(a.ws + WS_R3);
    bf16* Q = (bf16*)((unsigned char*)a.out + OUT_SBQ);
    LAS bf16* Ks = (LAS bf16*)lds;
    LAS bf16* VTs = (LAS bf16*)(lds + 17408);
    LAS bf16* Pw = (LAS bf16*)(lds + 35840 + wave * 4608);
    const int r32 = lane & 31, hh = lane >> 5, tid = wave * 64 + lane;
    const int tq0 = 256 * qb + 32 * wave, tq = tq0 + r32;
    const size_t rowb = (size_t)b * SEQ;
    bf16x8 qf[8];
#pragma unroll
    for (int ks = 0; ks < 8; ++ks) qf[ks] = *(const bf16x8*)(Q + (rowb + tq) * 1024 + h * 128 + 16 * ks + 8 * hh);
    f32x16 o[4];
#pragma unroll
    for (int dt = 0; dt < 4; ++dt) o[dt] = zero16();
    float carry = 0.f;
    const float scale = 0.08838834764831845f;
    for (int kt = 4 * qb + 3; kt >= 0; --kt) {
        __syncthreads();
        for (int i = tid; i < 1024; i += NTHR) { const int r = i >> 4, c = i & 15; *(LAS u32x4*)(Ks + r * 136 + c * 8) = *(const u32x4*)(K + (rowb + 64 * kt + r) * 1024 + h * 128 + c * 8); }
        for (int i = tid; i < 1024; i += NTHR) { const int r = i & 63, c = i >> 6; const u32x4 v = *(const u32x4*)(V + (rowb + 64 * kt + r) * 1024 + h * 128 + c * 8);
            const unsigned w4[4] = {v.x, v.y, v.z, v.w};
#pragma unroll
            for (int e = 0; e < 8; ++e) VTs[(c * 8 + e) * 72 + r] = (bf16)(w4[e >> 1] >> ((e & 1) * 16)); }
        __syncthreads();
        if (64 * kt >= tq0 + 31) continue;
        f32x16 p[2]; p[0] = zero16(); p[1] = zero16();
#pragma unroll
        for (int ks = 0; ks < 8; ++ks) { p[0] = MFMA32(ldsfrag(Ks + r32 * 136 + 16 * ks + 8 * hh), qf[ks], p[0]); p[1] = MFMA32(ldsfrag(Ks + (32 + r32) * 136 + 16 * ks + 8 * hh), qf[ks], p[1]); }
        f32x16 lf[2];
        float gs[2][4];
#pragma unroll
        for (int k = 0; k < 2; ++k)
#pragma unroll
            for (int g = 0; g < 4; ++g) { float s4 = 0.f;
#pragma unroll
                for (int j = 0; j < 4; ++j) { const int r = 4 * g + j; const float z = p[k][r] * scale; const float l1p = __logf(1.0f + __expf(-fabsf(z)));
                    const bool causal = (64 * kt + 32 * k + crow(r, hh)) < tq;
                    const float lbv = fminf(z, 0.f) - l1p, lfv = causal ? (fminf(-z, 0.f) - l1p) : 0.f;
                    p[k][r] = causal ? lbv : -1.0e30f; lf[k][r] = lfv; s4 += lfv; }
                gs[k][g] = s4; }
        float run = carry;
#pragma unroll
        for (int k = 1; k >= 0; --k)
#pragma unroll
            for (int g = 3; g >= 0; --g) { const float other = __shfl_xor(gs[k][g], 32);
                const float g_hi = hh ? gs[k][g] : other, g_lo = hh ? other : gs[k][g];
                float sv = hh ? run : run + g_hi;
                run += g_hi + g_lo;
#pragma unroll
                for (int j = 3; j >= 0; --j) { const int r = 4 * g + j; const float att = __expf(p[k][r] + sv); sv += lf[k][r]; p[k][r] = att; } }
        carry = run;
#pragma unroll
        for (int k = 0; k < 2; ++k)
#pragma unroll
            for (int g = 0; g < 4; ++g) { u32x2 w; w.x = pk2(p[k][4 * g], p[k][4 * g + 1]); w.y = pk2(p[k][4 * g + 2], p[k][4 * g + 3]); *(LAS u32x2*)(Pw + r32 * 72 + 32 * k + 8 * g + 4 * hh) = w; }
        LDS_WAIT();
#pragma unroll
        for (int ks = 0; ks < 4; ++ks) { const bf16x8 pa = ldsfrag(Pw + r32 * 72 + 16 * ks + 8 * hh);
#pragma unroll
            for (int dt = 0; dt < 4; ++dt) o[dt] = MFMA32(pa, ldsfrag(VTs + (32 * dt + r32) * 72 + 16 * ks + 8 * hh), o[dt]); }
        LDS_WAIT();
    }
#pragma unroll
    for (int dt = 0; dt < 4; ++dt)
#pragma unroll
        for (int r = 0; r < 16; ++r) { const size_t off = (rowb + tq0 + crow(r, hh)) * 1024 + h * 128 + 32 * dt + r32; Q[off] = (bf16)f2bf(o[dt][r] * siluf_(bf2f(Z[off]))); }
}
__device__ __forceinline__ void p2_attention(const Args& a, LAS unsigned char* lds, int vcu, int G, int wave, int lane) {
    for (int u = vcu; u < 256; u += G) mem_attn_unit(a, lds, u, wave, lane);
    for (int u = vcu; u < 512; u += G) { const int v = u & 255, bh = v >> 2, j = v & 3; sb_attn_unit(a, lds, bh >> 3, bh & 7, u < 256 ? j : 7 - j, wave, lane); }
    __syncthreads();
}
template <int I> struct SolveRows {
    static __device__ __forceinline__ void run(float (&Tc)[64], const LAS float* MT, int lane) {
        float acc[4] = {(I == lane) ? 1.f : 0.f, 0.f, 0.f, 0.f};
#pragma unroll
        for (int j4 = 0; j4 < (I + 3) / 4; ++j4) { const f32x4 m = *(const LAS f32x4*)(MT + I * 68 + 4 * j4);
            acc[0] -= m.x * Tc[4 * j4];
            if (4 * j4 + 1 < I) acc[1] -= m.y * Tc[4 * j4 + 1];
            if (4 * j4 + 2 < I) acc[2] -= m.z * Tc[4 * j4 + 2];
            if (4 * j4 + 3 < I) acc[3] -= m.w * Tc[4 * j4 + 3]; }
        Tc[I] = (acc[0] + acc[1]) + (acc[2] + acc[3]);
        asm volatile("" ::: "memory");
        SolveRows<I + 1>::run(Tc, MT, lane);
    }
};
template <> struct SolveRows<64> { static __device__ __forceinline__ void run(float (&)[64], const LAS float*, int) {} };
__device__ __forceinline__ void dn_prep_item(const Args& a, LAS unsigned char* lds, int item, int wave, int lane) {
    asm volatile("" : "+v"(lane));
    const int b = item >> 8, h = (item >> 5) & 7, n = item & 31; int tid = wave * 64 + lane;
    const size_t rowb = (size_t)b * SEQ + n * CH;
    bf16* R1 = (bf16*)(a.ws + WS_R1); bf16* R2 = (bf16*)(a.ws + WS_R2); bf16* R3 = (bf16*)(a.ws + WS_R3); bf16* R5 = (bf16*)(a.ws + WS_R5);
    const bf16* HALO = (const bf16*)(a.ws + WS_HALO); const float* BG = (const float*)(a.ws + WS_BG);
    bf16* AO = (bf16*)((unsigned char*)a.out + OUT_A) + (size_t)item * 4096;
    LAS bf16* QS = (LAS bf16*)lds;
    LAS bf16* KS = (LAS bf16*)(lds + 17408);
    LAS bf16* KBT = (LAS bf16*)(lds + 34816);
    LAS bf16* VBT = (LAS bf16*)(lds + 53248);
    LAS float* MT = (LAS float*)(lds + 71680);
    LAS bf16* TB = (LAS bf16*)(lds + 89088);
    LAS float* GL = (LAS float*)(lds + 98304);
    LAS float* BL = GL + 64;
    __syncthreads();
    if (wave == 0) {
        const float bb = BG[(rowb + lane) * 16 + h], aa = BG[(rowb + lane) * 16 + 8 + h];
        const float x = aa + a.in[I_DTBIAS][h];
        const float sp = fmaxf(x, 0.f) + log1pf(expf(-fabsf(x)));
        float g = -expf(a.in[I_ALOG][h]) * sp;
#pragma unroll
        for (int o = 1; o < 64; o <<= 1) { const float t = __shfl_up(g, o); if (lane >= o) g += t; }
        GL[lane] = g; BL[lane] = 1.0f / (1.0f + expf(-bb));
    }
    __syncthreads();
    {
        const int cc = tid & 15, rg = tid >> 4, r0 = 2 * rg;
        const float* cw = a.in[I_CONVW];
#pragma unroll 1
        for (int ten = 0; ten < 3; ++ten) {
            const bf16* src = ten == 0 ? R1 : (ten == 1 ? R2 : R3);
            const int gcol = h * 128 + cc * 8;
            float x[5][8];
#pragma unroll
            for (int j = 0; j < 5; ++j) { const int r = r0 - 3 + j; u32x4 v;
                if (r >= 0) v = *(const u32x4*)(src + (rowb + r) * 1024 + gcol);
                else if (n > 0) v = *(const u32x4*)(HALO + (size_t)((b * NCH + n - 1) * 3 + (r + 3)) * 3072 + ten * 1024 + gcol);
                else v = (u32x4){0u, 0u, 0u, 0u};
                const unsigned w4[4] = {v.x, v.y, v.z, v.w};
#pragma unroll
                for (int e = 0; e < 8; ++e) x[j][e] = __builtin_bit_cast(float, (w4[e >> 1] >> ((e & 1) * 16)) << 16); }
            float wq[4][8];
#pragma unroll
            for (int j = 0; j < 4; ++j) { const f32x4 w0 = *(const f32x4*)(cw + j * 3072 + ten * 1024 + gcol), w1 = *(const f32x4*)(cw + j * 3072 + ten * 1024 + gcol + 4);
                wq[j][0] = w0.x; wq[j][1] = w0.y; wq[j][2] = w0.z; wq[j][3] = w0.w; wq[j][4] = w1.x; wq[j][5] = w1.y; wq[j][6] = w1.z; wq[j][7] = w1.w; }
#pragma unroll
            for (int rr = 0; rr < 2; ++rr) { const int r = r0 + rr; float y[8]; float ss = 0.f;
#pragma unroll
                for (int e = 0; e < 8; ++e) { float s = 0.f;
#pragma unroll
                    for (int j = 0; j < 4; ++j) s += wq[j][e] * x[rr + j][e];
                    y[e] = s / (1.0f + __expf(-s)); ss += y[e] * y[e]; }
                if (ten < 2) { ss += __shfl_xor(ss, 1); ss += __shfl_xor(ss, 2); ss += __shfl_xor(ss, 4); ss += __shfl_xor(ss, 8);
                    const float sc = (1.0f / sqrtf(ss + NORM_EPS)) * (ten == 0 ? 0.08838834764831845f : 1.0f);
#pragma unroll
                    for (int e = 0; e < 8; ++e) y[e] *= sc;
                    u32x4 w; w.x = pk2(y[0], y[1]); w.y = pk2(y[2], y[3]); w.z = pk2(y[4], y[5]); w.w = pk2(y[6], y[7]);
                    *(LAS u32x4*)((ten == 0 ? QS : KS) + r * 136 + cc * 8) = w;
                    if (ten == 1) { const float f = BL[r] * __expf(GL[r]);
#pragma unroll
                        for (int e = 0; e < 8; ++e) KBT[(cc * 8 + e) * 72 + r] = (bf16)f2bf(y[e] * f); }
                } else { const float f = BL[r];
#pragma unroll
                    for (int e = 0; e < 8; ++e) VBT[(cc * 8 + e) * 72 + r] = (bf16)f2bf(y[e] * f); } }
        }
    }
    __syncthreads();
    int r32 = lane & 31, hh = lane >> 5;
    {
        const int which = wave >> 2, ti = (wave >> 1) & 1, tj = wave & 1;
        const LAS bf16* X = which ? QS : KS;
        f32x16 c = zero16();
#pragma unroll
        for (int ks = 0; ks < 8; ++ks) c = MFMA32(ldsfrag(X + (32 * ti + r32) * 136 + 16 * ks + 8 * hh), ldsfrag(KS + (32 * tj + r32) * 136 + 16 * ks + 8 * hh), c);
        const int j = 32 * tj + r32; const float Gj = GL[j];
#pragma unroll
        for (int r = 0; r < 16; ++r) { const int i = 32 * ti + crow(r, hh); const float Gi = GL[i];
            if (which == 0) MT[i * 68 + j] = (i > j) ? BL[i] * c[r] * __expf(Gi - Gj) : 0.f;
            else AO[i * 64 + j] = (bf16)f2bf((i >= j) ? c[r] * __expf(Gi - Gj) : 0.f); }
    }
    __syncthreads();
    if (wave == 0) {
        float Tc[64];
        SolveRows<0>::run(Tc, MT, lane);
#pragma unroll
        for (int i = 0; i < 64; ++i) TB[i * 72 + lane] = (bf16)f2bf(Tc[i]);
    }
    __syncthreads();
    asm volatile("" : "+v"(lane)); r32 = lane & 31; hh = lane >> 5; tid = wave * 64 + lane;
    {
        { const int ei = wave >> 1, cj = wave & 1; f32x16 c = zero16();
#pragma unroll
          for (int ks = 0; ks < 4; ++ks) c = MFMA32(ldsfrag(VBT + (32 * ei + r32) * 72 + 16 * ks + 8 * hh), ldsfrag(TB + (32 * cj + r32) * 72 + 16 * ks + 8 * hh), c);
#pragma unroll
          for (int r = 0; r < 16; ++r) { const int e = 32 * ei + crow(r, hh), cidx = 32 * cj + r32; R3[(rowb + (e >> 1)) * 1024 + h * 128 + (e & 1) * 64 + cidx] = (bf16)f2bf(c[r]); } }
        { const int ci = wave >> 2, dj = wave & 3; f32x16 c = zero16();
#pragma unroll
          for (int ks = 0; ks < 4; ++ks) c = MFMA32(ldsfrag(TB + (32 * ci + r32) * 72 + 16 * ks + 8 * hh), ldsfrag(KBT + (32 * dj + r32) * 72 + 16 * ks + 8 * hh), c);
#pragma unroll
          for (int r = 0; r < 16; ++r) { const int cidx = 32 * ci + crow(r, hh), d = 32 * dj + r32; R2[(rowb + cidx) * 1024 + h * 128 + d] = (bf16)f2bf(c[r]); } }
    }
    {
        const float Glast = GL[63];
        for (int i = tid; i < 1024; i += NTHR) { const int r = i >> 4, c8 = i & 15; const float f = __expf(GL[r]);
            const u32x4 v = *(const LAS u32x4*)(QS + r * 136 + c8 * 8); const unsigned w4[4] = {v.x, v.y, v.z, v.w}; float y[8];
#pragma unroll
            for (int e = 0; e < 8; ++e) y[e] = __builtin_bit_cast(float, (w4[e >> 1] >> ((e & 1) * 16)) << 16) * f;
            u32x4 w; w.x = pk2(y[0], y[1]); w.y = pk2(y[2], y[3]); w.z = pk2(y[4], y[5]); w.w = pk2(y[6], y[7]);
            *(u32x4*)(R1 + (rowb + r) * 1024 + h * 128 + c8 * 8) = w; }
        for (int i = tid; i < 1024; i += NTHR) { const int d = i & 127, c8 = i >> 7; float y[8];
#pragma unroll
            for (int e = 0; e < 8; ++e) { const int c = c8 * 8 + e; y[e] = bf2f(KS[c * 136 + d]) * __expf(Glast - GL[c]); }
            u32x4 w; w.x = pk2(y[0], y[1]); w.y = pk2(y[2], y[3]); w.z = pk2(y[4], y[5]); w.w = pk2(y[6], y[7]);
            *(u32x4*)(R5 + (rowb + (d >> 1)) * 1024 + h * 128 + (d & 1) * 64 + c8 * 8) = w; }
        if (tid == 0) ((float*)(a.ws + WS_DECAY))[item] = __expf(Glast);
    }
}

__device__ __forceinline__ void dn_scan_unit(const Args& a, LAS unsigned char* lds, int bh, int wave, int lane) {
    const int b = bh >> 3, h = bh & 7;
    const bf16* R1 = (const bf16*)(a.ws + WS_R1); const bf16* R2 = (const bf16*)(a.ws + WS_R2); const bf16* R3 = (const bf16*)(a.ws + WS_R3); const bf16* R5 = (const bf16*)(a.ws + WS_R5);
    bf16* R4 = (bf16*)(a.ws + WS_R4);
    const float* DEC = (const float*)(a.ws + WS_DECAY);
    LAS bf16* Wl = (LAS bf16*)lds;
    LAS bf16* QDl = (LAS bf16*)(lds + 17408);
    LAS bf16* Al = (LAS bf16*)(lds + 34816);
    LAS bf16* KDTl = (LAS bf16*)(lds + 44032);
    LAS bf16* UTl = (LAS bf16*)(lds + 62464);
    LAS bf16* STB = (LAS bf16*)(lds + 80896);
    LAS bf16* VN = (LAS bf16*)(lds + 115712);
    LAS float* SSQ = (LAS float*)(lds + 134144);
    int r32 = lane & 31, hh = lane >> 5, tid = wave * 64 + lane; const int e0 = 32 * wave;
    f32x16 S[4];
#pragma unroll
    for (int dj = 0; dj < 4; ++dj) S[dj] = zero16();
    __syncthreads();
    for (int i = tid; i < 128 * 136 / 2; i += NTHR) ((LAS unsigned*)STB)[i] = 0u;
    for (int n = 0; n < NCH; ++n) {
        asm volatile("" : "+v"(lane)); r32 = lane & 31; hh = lane >> 5; tid = wave * 64 + lane;
        const size_t rowb = (size_t)b * SEQ + n * CH; const int item = (b * 8 + h) * NCH + n;
        const bf16* AO = (const bf16*)((const unsigned char*)a.out + OUT_A) + (size_t)item * 4096;
        __syncthreads();
        for (int i = tid; i < 1024; i += NTHR) { const int r = i >> 4, c8 = i & 15;
            *(LAS u32x4*)(Wl + r * 136 + c8 * 8) = *(const u32x4*)(R2 + (rowb + r) * 1024 + h * 128 + c8 * 8);
            *(LAS u32x4*)(QDl + r * 136 + c8 * 8) = *(const u32x4*)(R1 + (rowb + r) * 1024 + h * 128 + c8 * 8); }
        for (int i = tid; i < 1024; i += NTHR) { const int e = i >> 3, c8 = i & 7; const size_t g = (rowb + (e >> 1)) * 1024 + h * 128 + (e & 1) * 64 + c8 * 8;
            *(LAS u32x4*)(UTl + e * 72 + c8 * 8) = *(const u32x4*)(R3 + g);
            *(LAS u32x4*)(KDTl + e * 72 + c8 * 8) = *(const u32x4*)(R5 + g); }
        for (int i = tid; i < 512; i += NTHR) { const int r = i >> 3, c8 = i & 7; *(LAS u32x4*)(Al + r * 72 + c8 * 8) = *(const u32x4*)(AO + r * 64 + c8 * 8); }
        const float decay = DEC[item];
        __syncthreads();
        f32x16 oT[2];
        if (wave < 4) {
#pragma unroll
            for (int cj = 0; cj < 2; ++cj) { f32x16 c = zero16();
#pragma unroll
                for (int ks = 0; ks < 8; ++ks) c = MFMA32(ldsfrag(STB + (e0 + r32) * 136 + 16 * ks + 8 * hh), ldsfrag(Wl + (32 * cj + r32) * 136 + 16 * ks + 8 * hh), c);
#pragma unroll
                for (int r = 0; r < 16; ++r) { const int e = e0 + crow(r, hh), cidx = 32 * cj + r32; VN[e * 72 + cidx] = (bf16)f2bf(bf2f(UTl[e * 72 + cidx]) - c[r]); } }
            LDS_WAIT();
#pragma unroll
            for (int ci = 0; ci < 2; ++ci) { f32x16 c = zero16();
#pragma unroll
                for (int ks = 0; ks < 8; ++ks) c = MFMA32(ldsfrag(STB + (e0 + r32) * 136 + 16 * ks + 8 * hh), ldsfrag(QDl + (32 * ci + r32) * 136 + 16 * ks + 8 * hh), c);
#pragma unroll
                for (int ks = 0; ks < 4; ++ks) c = MFMA32(ldsfrag(VN + (e0 + r32) * 72 + 16 * ks + 8 * hh), ldsfrag(Al + (32 * ci + r32) * 72 + 16 * ks + 8 * hh), c);
                oT[ci] = c; }
#pragma unroll
            for (int dj = 0; dj < 4; ++dj) { f32x16 c = S[dj] * decay;
#pragma unroll
                for (int ks = 0; ks < 4; ++ks) c = MFMA32(ldsfrag(VN + (e0 + r32) * 72 + 16 * ks + 8 * hh), ldsfrag(KDTl + (32 * dj + r32) * 72 + 16 * ks + 8 * hh), c);
                S[dj] = c; }
            LDS_WAIT();
#pragma unroll
            for (int dj = 0; dj < 4; ++dj)
#pragma unroll
                for (int r = 0; r < 16; ++r) STB[(e0 + crow(r, hh)) * 136 + 32 * dj + r32] = (bf16)f2bf(S[dj][r]);
#pragma unroll
            for (int ci = 0; ci < 2; ++ci) { float s = 0.f;
#pragma unroll
                for (int r = 0; r < 16; ++r) s += oT[ci][r] * oT[ci][r];
                s += __shfl_xor(s, 32);
                if (hh == 0) SSQ[wave * 64 + 32 * ci + r32] = s; }
        }
        __syncthreads();
        asm volatile("" : "+v"(lane)); r32 = lane & 31; hh = lane >> 5;
        if (wave < 4) {
#pragma unroll
            for (int ci = 0; ci < 2; ++ci) { const int cidx = 32 * ci + r32;
                const float ss = (SSQ[cidx] + SSQ[64 + cidx]) + (SSQ[128 + cidx] + SSQ[192 + cidx]);
                const float rs = 1.0f / sqrtf(ss * (1.0f / 128.0f) + NORM_EPS);
#pragma unroll
                for (int r = 0; r < 16; ++r) { const int e = e0 + crow(r, hh); const size_t off = (rowb + cidx) * 1024 + h * 128 + e;
                    const float z = bf2f(R4[off]); R4[off] = (bf16)f2bf(oT[ci][r] * rs * a.in[I_DNNORMG][e] * (z / (1.0f + __expf(-z)))); } }
        }
    }
    __syncthreads();
}
__global__ void __launch_bounds__(NTHR, 2) hyb_fwd(Args args) {
    extern __shared__ __attribute__((aligned(16))) unsigned char lds_raw[];
    LAS unsigned char* lds = (LAS unsigned char*)lds_raw;
    const int wave = __builtin_amdgcn_readfirstlane((int)threadIdx.x >> 6);
    const int lane = lane_id();
    const int G = gridDim.x, bx = blockIdx.x, vcu = (G % 8 == 0) ? (bx % 8) * (G / 8) + bx / 8 : bx;
    const int lo = args.ph_lo, hi = args.ph_hi;
#define IN(k) (lo <= (k) && (k) < hi)
#if MK_N_LAUNCHES == 1
#define SEAM(k) do { if (IN(k) && IN((k) + 1)) cg::this_grid().sync(); } while (0)
#else
#define SEAM(k) do { } while (0)
#endif
    unsigned char* ws = args.ws; unsigned char* ob = (unsigned char*)args.out;
    bf16* HN = (bf16*)(ws + WS_HN);
    if (IN(PH_PRO)) { p0_prologue(args, lds, vcu, G, wave, lane); }
    SEAM(PH_PRO);
    if (IN(PH_GEMM1)) {
        pg8::Gemm g{HN, (const bf16*)(ws + WS_W1T), M, N1, 1024}; pg8::StaticOrder S; S.init(M, N1, G, bx);
        pg8::EpiG1 E{(bf16*)(ob + OUT_SBQ), (bf16*)(ws + WS_R1), (bf16*)(ws + WS_R2), (bf16*)(ws + WS_R3), (bf16*)(ob + OUT_MQ), (bf16*)(ob + OUT_MZ)};
        pg8::gemm_phase<pg8::EpiG1, pg8::StaticOrder, true, true>(lds, g, S, E, wave);
        pg8::Gemm g2{(const bf16*)(ws + WS_MEMN), (const bf16*)(ws + WS_WMKVT), MROWS, 512, 1024}; pg8::StaticOrder S2; S2.init(MROWS, 512, G, G - 1 - bx);
        pg8::EpiMKV E2{(bf16*)(ws + WS_MK)};
        pg8::gemm_phase<pg8::EpiMKV, pg8::StaticOrder, true, true>(lds, g2, S2, E2, wave);
    }
    SEAM(PH_GEMM1);
    if (IN(PH_ATTN)) { p2_attention(args, lds, vcu, G, wave, lane); }
    SEAM(PH_ATTN);
    if (IN(PH_GEMM3)) {
        pg8::Gemm g{HN, (const bf16*)(ws + WS_W3T), M, N3, 1024}; pg8::StaticOrder S; S.init(M, N3, G, bx);
        pg8::EpiG3 E{(bf16*)(ws + WS_R1), (bf16*)(ws + WS_R2), (bf16*)(ws + WS_R3), (bf16*)(ws + WS_R4), (bf16*)(ws + WS_HALO)};
        pg8::gemm_phase<pg8::EpiG3, pg8::StaticOrder, true, true>(lds, g, S, E, wave);
    }
    SEAM(PH_GEMM3);
    if (IN(PH_PREP)) { for (int it = vcu; it < BATCH * NHEAD * NCH; it += G) dn_prep_item(args, lds, it, wave, lane); __syncthreads(); }
    SEAM(PH_PREP);
    if (IN(PH_SCAN)) { for (int u = bx; u < BATCH * NHEAD; u += G) dn_scan_unit(args, lds, u, wave, lane); }
    SEAM(PH_SCAN);
    if (IN(PH_MERGE)) {
        pg8::StaticOrder S; S.init(M, 1024, G, bx);
        bf16* Gs = (bf16*)(ws + WS_R1); float* Ms = (float*)(ws + WS_R2); bf16* MERGED = (bf16*)(ws + WS_R5);
        const bf16* WG = (const bf16*)(ws + WS_WGT);
        { pg8::Gemm g{HN, WG, M, 1024, 1024}; pg8::EpiGate E{Gs, 1024}; pg8::gemm_phase<pg8::EpiGate, pg8::StaticOrder, true, true>(lds, g, S, E, wave); }
        { pg8::Gemm g{(const bf16*)(ws + WS_R4), (const bf16*)(ws + WS_WBDN), M, 1024, 1024}; pg8::EpiMerge<0> E{Gs, Ms, MERGED, 1024}; pg8::gemm_phase<pg8::EpiMerge<0>, pg8::StaticOrder, true, true>(lds, g, S, E, wave); }
        { pg8::Gemm g{HN, WG + (size_t)1 * 1024 * 1024, M, 1024, 1024}; pg8::EpiGate E{Gs, 1024}; pg8::gemm_phase<pg8::EpiGate, pg8::StaticOrder, true, true>(lds, g, S, E, wave); }
        { pg8::Gemm g{(const bf16*)(ob + OUT_SBQ), (const bf16*)(ws + WS_WBSB), M, 1024, 1024}; pg8::EpiMerge<1> E{Gs, Ms, MERGED, 1024}; pg8::gemm_phase<pg8::EpiMerge<1>, pg8::StaticOrder, true, true>(lds, g, S, E, wave); }
        { pg8::Gemm g{HN, WG + (size_t)2 * 1024 * 1024, M, 1024, 1024}; pg8::EpiGate E{Gs, 1024}; pg8::gemm_phase<pg8::EpiGate, pg8::StaticOrder, true, true>(lds, g, S, E, wave); }
        { pg8::Gemm g{(const bf16*)(ob + OUT_MQ), (const bf16*)(ws + WS_WBM), M, 1024, 256}; pg8::EpiMerge<2> E{Gs, Ms, MERGED, 1024}; pg8::gemm_phase<pg8::EpiMerge<2>, pg8::StaticOrder, true, true>(lds, g, S, E, wave); }
    }
    SEAM(PH_MERGE);
    if (IN(PH_OUT)) {
        pg8::StaticOrder S; S.init(M, 1024, G, bx);
        pg8::Gemm g{(const bf16*)(ws + WS_R5), (const bf16*)(ws + WS_WOUT), M, 1024, 1024}; pg8::EpiResid E{args.in[I_X], args.out, 1024};
        pg8::gemm_phase<pg8::EpiResid, pg8::StaticOrder, true, true>(lds, g, S, E, wave);
    }
    SEAM(PH_OUT);
    if (IN(PH_NORM)) { p8_final_norm(args, args.out, vcu, G, wave, lane); }
#undef IN
#undef SEAM
}

extern "C" void kernel_launch(void* const* d_in, const int* in_sizes, int n_in, void* d_out, int out_size, void* d_ws, size_t ws_size, hipStream_t stream) {
    static int grid = 0;
    if (grid == 0) {
        if (n_in != 15 || in_sizes[0] != M * DM || out_size != M * DM || ws_size < WS_END) { fprintf(stderr, "kernel_launch: unexpected shapes (n_in %d, in0 %d, out %d, ws %zu)\n", n_in, n_in > 0 ? in_sizes[0] : -1, out_size, ws_size); grid = -1; return; }
        int dev = 0, cus = 0, per_cu = 0;
        if (hipGetDevice(&dev) != hipSuccess || hipDeviceGetAttribute(&cus, hipDeviceAttributeMultiprocessorCount, dev) != hipSuccess) { grid = -1; return; }
        if (hipFuncSetAttribute((const void*)hyb_fwd, hipFuncAttributeMaxDynamicSharedMemorySize, LDS_BYTES) != hipSuccess) { fprintf(stderr, "kernel_launch: hipFuncSetAttribute failed\n"); grid = -1; return; }
        if (hipOccupancyMaxActiveBlocksPerMultiprocessor(&per_cu, (const void*)hyb_fwd, NTHR, LDS_BYTES) != hipSuccess || per_cu < 1) { fprintf(stderr, "kernel_launch: occupancy query says %d blocks per CU\n", per_cu); (void)hipGetLastError(); grid = -1; return; }
        grid = cus * 1;
    }
    if (grid < 0) return;
    (void)hipMemsetAsync((char*)d_ws + WS_CTL, 0, CTL_ZERO_BYTES, stream);
    Args a{};
    for (int i = 0; i < 15; ++i) a.in[i] = (const float*)d_in[i];
    a.out = (float*)d_out; a.ws = (unsigned char*)d_ws;
#if MK_N_LAUNCHES == 1
    a.ph_lo = 0; a.ph_hi = PH_COUNT;
    void* kargs[] = {&a};
    hipError_t e = hipLaunchCooperativeKernel((const void*)hyb_fwd, dim3(grid), dim3(NTHR), kargs, LDS_BYTES, stream);
    if (e != hipSuccess) fprintf(stderr, "kernel_launch: cooperative launch failed: %s (grid %d)\n", hipGetErrorString(e), grid);
#else
    for (int p = 0; p < PH_COUNT; ++p) {
        a.ph_lo = p; a.ph_hi = p + 1;
        hipLaunchKernelGGL(hyb_fwd, dim3(grid), dim3(NTHR), LDS_BYTES, stream, a);
    }
#endif
}
```

```cpp
#include <hip/hip_runtime.h>
#include <hip/hip_cooperative_groups.h>
#include <cstdio>
#include <cstdint>
namespace cg = cooperative_groups;
namespace pg8 {
#define PG8_LAS __attribute__((address_space(3)))
typedef unsigned short bf16_t;
typedef short bf16x8 __attribute__((ext_vector_type(8)));
typedef float f32x4 __attribute__((ext_vector_type(4)));
typedef unsigned u32x4 __attribute__((ext_vector_type(4)));
constexpr int BM = 256, BK = 64, HALF = 128, HTB = HALF * BK * 2  , STAGE_BYTES = 8 * HTB, NXCD = 8, WGM = 8;

__host__ __device__ __forceinline__ int lds_byte(int r, int c) { const int st = (r >> 4) * 2 + (c >> 5), rr = r & 15, cc = c & 31, ob = rr * 64 + cc * 2; return st * 1024 + (ob ^ (((ob >> 9) & 1) << 5)); }
__host__ __device__ __forceinline__ void stage_rc(int b, int& R, int& C) { const int st = b / 1024, sb = b % 1024, swz = sb ^ (((sb >> 9) & 1) << 5); R = (st >> 1) * 16 + swz / 64; C = (st & 1) * 32 + (swz % 64) / 2; }
__host__ __device__ __forceinline__ int perm32(int rho) { const int n = rho >> 4, i = rho & 15; return 8 * (i >> 2) + 4 * n + (i & 3); }

struct Unit { int pm, pn; };
struct Gemm { const bf16_t* A; const bf16_t* Bt; int M, N, K; };

struct StaticOrder {
    int nM, nN, nwg, G, c;
    __host__ __device__ void init(int M, int N, int G_, int c_) { nM = M / BM; nN = N / BM; nwg = nM * nN; G = G_; c = c_; }
    __host__ __device__ bool next(int i, Unit& u) const {
        const long L = (long)i * G + c; if (L >= nwg) return false;
        int wgid = (int)L; { const int q = nwg / NXCD, r = nwg % NXCD, xcd = wgid % NXCD, off = wgid / NXCD; wgid = (xcd < r ? xcd * (q + 1) : r * (q + 1) + (xcd - r) * q) + off; }
        const int nig = WGM * nN, gid = wgid / nig, fm = gid * WGM, gsz = (nM - fm) < WGM ? (nM - fm) : WGM;
        u.pm = fm + ((wgid % nig) % gsz); u.pn = (wgid % nig) / gsz; return true;
    }
    __device__ __forceinline__ void a_ready(const Unit&) const {}
    __device__ __forceinline__ void done(const Unit&) const {}
};

__device__ __forceinline__ unsigned cvt_pk_bf16(float lo, float hi) { unsigned r; asm volatile("v_cvt_pk_bf16_f32 %0, %1, %2" : "=v"(r) : "v"(lo), "v"(hi)); return r; }
template <class Epi, class Sched, bool ALIGN_EPI = false, bool SP2 = false>
__device__ __forceinline__ void gemm_phase(PG8_LAS unsigned char* lds, const Gemm g, const Sched& S, const Epi& E, const int wid  ) {
    const int lane = (int)__builtin_amdgcn_mbcnt_hi(~0u, __builtin_amdgcn_mbcnt_lo(~0u, 0u)), tid = wid * 64 + lane, wr = wid >> 2, wc = wid & 3, fr = lane & 15, fq = lane >> 4;
    const int K = g.K, nt = K / BK;
    unsigned voffA[2], voffB[2];
#pragma unroll
    for (int i = 0; i < 2; ++i) { int R, C; stage_rc(tid * 16 + i * 8192, R, C); const int Rb = Epi::PERM ? ((R & ~31) + perm32(R & 31)) : R;
        voffA[i] = (unsigned)(R * K + C) * 2u; voffB[i] = (unsigned)(Rb * K + C) * 2u; }
    const size_t kstep = (size_t)(BK * 2);
    const size_t hstep = (size_t)HALF * K * 2;
    const size_t tstep = 2 * hstep;
    const unsigned ldsw = (unsigned)wid * 1024u;
    const int aoff = lds_byte(wr * 64 + fr, fq * 8), boff = lds_byte(wc * 32 + fr, fq * 8);
#define PG8_SA(b, h) (((b) * 2 + (h)) * HTB)
#define PG8_SB(b, h) ((4 + (b) * 2 + (h)) * HTB)
#define PG8_STAGE(bufoff, gbase, voff) do { _Pragma("unroll") for (int _i = 0; _i < 2; ++_i) \
        __builtin_amdgcn_global_load_lds((const unsigned*)((const char*)(gbase) + (voff)[_i]), (PG8_LAS unsigned*)(lds + (bufoff) + ldsw + _i * 8192), 16, 0, 0); } while (0)
#define PG8_LDA(dst, b, h) do { _Pragma("unroll") for (int m = 0; m < 4; ++m) _Pragma("unroll") for (int k = 0; k < 2; ++k) dst[m][k] = *(const PG8_LAS bf16x8*)(lds + PG8_SA(b, h) + aoff + m * 2048 + k * 1024); } while (0)
#define PG8_LDB(dst, b, h) do { _Pragma("unroll") for (int n = 0; n < 2; ++n) _Pragma("unroll") for (int k = 0; k < 2; ++k) dst[n][k] = *(const PG8_LAS bf16x8*)(lds + PG8_SB(b, h) + boff + n * 2048 + k * 1024); } while (0)
#define PG8_MMA(ai, bj, At, Bt) do { __builtin_amdgcn_s_setprio(1); _Pragma("unroll") for (int m = 0; m < 4; ++m) _Pragma("unroll") for (int n = 0; n < 2; ++n) _Pragma("unroll") for (int k = 0; k < 2; ++k) \
        acc[ai][bj][m][n] = __builtin_amdgcn_mfma_f32_16x16x32_bf16(Bt[n][k], At[m][k], acc[ai][bj][m][n], 0, 0, 0); __builtin_amdgcn_s_setprio(0); } while (0)
#define PG8_WAIT_V(n) asm volatile("s_waitcnt vmcnt(" #n ")" ::: "memory")
#define PG8_WAIT_L(n) asm volatile("s_waitcnt lgkmcnt(" #n ")" ::: "memory")
#define PG8_BAR __builtin_amdgcn_s_barrier()
#define PG8_SCHED __builtin_amdgcn_sched_barrier(0)
    Unit cur, nxt; int ui = 0;
    if (!S.next(0, cur)) return;
    f32x4 acc[2][2][4][2];
#pragma unroll
    for (int a = 0; a < 2; ++a)
#pragma unroll
        for (int b = 0; b < 2; ++b)
#pragma unroll
            for (int m = 0; m < 4; ++m)
#pragma unroll
                for (int n = 0; n < 2; ++n) acc[a][b][m][n] = (f32x4){0.f, 0.f, 0.f, 0.f};
    bf16x8 At[4][2], B0[2][2], B1[2][2];
    const char* cA = (const char*)g.A + (size_t)cur.pm * tstep; const char* cB = (const char*)g.Bt + (size_t)cur.pn * tstep;
    S.a_ready(cur);
    if constexpr (SP2) {
        PG8_STAGE(PG8_SB(0, 0), cB, voffB); PG8_STAGE(PG8_SB(0, 1), cB + hstep, voffB); PG8_STAGE(PG8_SA(0, 0), cA, voffA); PG8_STAGE(PG8_SA(0, 1), cA + hstep, voffA);
        if (wr == 1) PG8_BAR;
        PG8_WAIT_V(2); PG8_BAR;
        PG8_STAGE(PG8_SB(1, 0), cB + kstep, voffB); PG8_STAGE(PG8_SA(1, 0), cA + kstep, voffA); PG8_STAGE(PG8_SB(1, 1), cB + hstep + kstep, voffB);
        PG8_WAIT_V(6); PG8_BAR;
    } else {
        PG8_STAGE(PG8_SB(0, 0), cB, voffB); PG8_STAGE(PG8_SA(0, 0), cA, voffA); PG8_STAGE(PG8_SB(0, 1), cB + hstep, voffB); PG8_STAGE(PG8_SA(0, 1), cA + hstep, voffA);
        if (wr == 1) PG8_BAR;
        PG8_WAIT_V(4); PG8_BAR;
        PG8_STAGE(PG8_SB(1, 0), cB + kstep, voffB); PG8_STAGE(PG8_SA(1, 0), cA + kstep, voffA); PG8_STAGE(PG8_SB(1, 1), cB + hstep + kstep, voffB);
        PG8_WAIT_V(6); PG8_BAR;
    }
    for (;;) {
        const bool has_next = S.next(ui + 1, nxt);
        const char* nA = has_next ? (const char*)g.A + (size_t)nxt.pm * tstep : cA; const char* nB = has_next ? (const char*)g.Bt + (size_t)nxt.pn * tstep : cB;
        for (int t = 0; t < nt; t += 2) {
            const bool last = (t == nt - 2);
            const char* a1 = cA + (size_t)(t + 1) * kstep;
            const char* a2 = last ? nA : cA + (size_t)(t + 2) * kstep; const char* b2 = last ? nB : cB + (size_t)(t + 2) * kstep;
            const char* a3 = a2 + kstep; const char* b3 = b2 + kstep;
            if (last && has_next) S.a_ready(nxt);
            if constexpr (SP2) {
            PG8_LDB(B0, 0, 0); PG8_LDB(B1, 0, 1); PG8_SCHED; PG8_LDA(At, 0, 0); PG8_STAGE(PG8_SA(1, 1), a1 + hstep, voffA);
            PG8_WAIT_V(8); PG8_WAIT_L(0); PG8_BAR; PG8_MMA(0, 0, At, B0); PG8_MMA(0, 1, At, B1); PG8_BAR; PG8_SCHED;
            PG8_LDA(At, 0, 1); PG8_STAGE(PG8_SB(0, 0), b2, voffB); PG8_STAGE(PG8_SB(0, 1), b2 + hstep, voffB); PG8_STAGE(PG8_SA(0, 0), a2, voffA);
            PG8_WAIT_V(8); PG8_WAIT_L(0); PG8_BAR; PG8_MMA(1, 0, At, B0); PG8_MMA(1, 1, At, B1); PG8_BAR; PG8_SCHED;
            PG8_LDB(B0, 1, 0); PG8_LDB(B1, 1, 1); PG8_SCHED; PG8_LDA(At, 1, 0); PG8_STAGE(PG8_SA(0, 1), a2 + hstep, voffA);
            PG8_WAIT_V(8); PG8_WAIT_L(0); PG8_BAR; PG8_MMA(0, 0, At, B0); PG8_MMA(0, 1, At, B1); PG8_BAR; PG8_SCHED;
            PG8_LDA(At, 1, 1); PG8_STAGE(PG8_SB(1, 0), b3, voffB); PG8_STAGE(PG8_SB(1, 1), b3 + hstep, voffB); PG8_STAGE(PG8_SA(1, 0), a3, voffA);
            PG8_WAIT_V(8); PG8_WAIT_L(0); PG8_BAR; PG8_MMA(1, 0, At, B0); PG8_MMA(1, 1, At, B1); PG8_BAR; PG8_SCHED;
            } else {
            PG8_LDB(B0, 0, 0); PG8_SCHED; PG8_LDA(At, 0, 0); PG8_STAGE(PG8_SA(1, 1), a1 + hstep, voffA);
            PG8_WAIT_L(8); PG8_BAR; PG8_WAIT_L(0); PG8_MMA(0, 0, At, B0); PG8_BAR; PG8_SCHED;
            PG8_LDB(B1, 0, 1); PG8_STAGE(PG8_SB(0, 0), b2, voffB);
            PG8_BAR; PG8_WAIT_L(0); PG8_MMA(0, 1, At, B1); PG8_BAR;
            PG8_LDA(At, 0, 1); PG8_STAGE(PG8_SA(0, 0), a2, voffA);
            PG8_BAR; PG8_WAIT_L(0); PG8_MMA(1, 0, At, B0); PG8_BAR; PG8_SCHED;
            PG8_STAGE(PG8_SB(0, 1), b2 + hstep, voffB);
            PG8_WAIT_V(6); PG8_BAR; PG8_MMA(1, 1, At, B1); PG8_BAR;
            PG8_LDB(B0, 1, 0); PG8_SCHED; PG8_LDA(At, 1, 0); PG8_STAGE(PG8_SA(0, 1), a2 + hstep, voffA);
            PG8_WAIT_L(8); PG8_BAR; PG8_WAIT_L(0); PG8_MMA(0, 0, At, B0); PG8_BAR; PG8_SCHED;
            PG8_LDB(B1, 1, 1); PG8_STAGE(PG8_SB(1, 0), b3, voffB);
            PG8_BAR; PG8_WAIT_L(0); PG8_MMA(0, 1, At, B1); PG8_BAR;
            PG8_LDA(At, 1, 1); PG8_STAGE(PG8_SA(1, 0), a3, voffA);
            PG8_BAR; PG8_WAIT_L(0); PG8_MMA(1, 0, At, B0); PG8_BAR; PG8_SCHED;
            PG8_STAGE(PG8_SB(1, 1), b3 + hstep, voffB);
            PG8_WAIT_V(6); PG8_BAR; PG8_MMA(1, 1, At, B1); PG8_BAR;
            }
        }
        if constexpr (ALIGN_EPI) { if (wr == 0) PG8_BAR; }
        if constexpr (!Epi::AFTER_DRAIN) { E(acc, cur, wr, wc, fr, fq); S.done(cur); }
        if (!has_next) break;
#pragma unroll
        for (int a = 0; a < 2; ++a)
#pragma unroll
            for (int b = 0; b < 2; ++b)
#pragma unroll
                for (int m = 0; m < 4; ++m)
#pragma unroll
                    for (int n = 0; n < 2; ++n) acc[a][b][m][n] = (f32x4){0.f, 0.f, 0.f, 0.f};
        cur = nxt; cA = nA; cB = nB; ++ui;
        if constexpr (ALIGN_EPI) { if (wr == 1) PG8_BAR; }
    }
    PG8_WAIT_V(0);
    if constexpr (!ALIGN_EPI) { if (wr == 0) PG8_BAR; }
    PG8_BAR;
    if constexpr (Epi::AFTER_DRAIN) { E.fused(acc, cur, wr, wc, fr, fq, lds, wid, lane); S.done(cur); }
#undef PG8_SA
#undef PG8_SB
#undef PG8_STAGE
#undef PG8_LDA
#undef PG8_LDB
#undef PG8_MMA
#undef PG8_WAIT_V
#undef PG8_WAIT_L
#undef PG8_BAR
#undef PG8_SCHED
}
}
namespace pg8 {
__device__ __forceinline__ unsigned short bf_rne(float f) { unsigned u = __builtin_bit_cast(unsigned, f); return (unsigned short)((u + 0x7fffu + ((u >> 16) & 1u)) >> 16); }
__device__ __forceinline__ u32x4 pack8(const f32x4& v0, const f32x4& v1) { u32x4 w; w.x = cvt_pk_bf16(v0[0], v0[1]); w.y = cvt_pk_bf16(v0[2], v0[3]); w.z = cvt_pk_bf16(v1[0], v1[1]); w.w = cvt_pk_bf16(v1[2], v1[3]); return w; }
__device__ __forceinline__ void store_tile_bf16(const f32x4 (&acc)[2][2][4][2], const Unit& u, int wr, int wc, int fr, int fq, bf16_t* base, int ld, int col0, bool tr, int hd, int nh, int srows, bf16_t* halo, int halo_col0) {
    const int row0 = u.pm * BM + wr * 64 + fr, cl0 = wc * 32 + 8 * fq;
#pragma unroll
    for (int ai = 0; ai < 2; ++ai)
#pragma unroll
        for (int m = 0; m < 4; ++m) { const int row = row0 + ai * HALF + m * 16;
#pragma unroll
            for (int bj = 0; bj < 2; ++bj) { const f32x4 v0 = acc[ai][bj][m][0], v1 = acc[ai][bj][m][1]; const int c = col0 + cl0 + bj * HALF;
                { const u32x4 w = pack8(v0, v1); *(u32x4*)(base + (size_t)row * ld + c) = w;
                    if (halo && (row & 63) >= 61) *(u32x4*)(halo + (size_t)((row >> 6) * 3 + (row & 63) - 61) * 3072 + halo_col0 + cl0 + bj * HALF) = w;
                } } }
}
struct EpiG1 {
    static constexpr bool PERM = true, AFTER_DRAIN = false;
    bf16_t *Q, *K, *VT, *Z, *MQ, *MZ;
    __device__ __forceinline__ void operator()(const f32x4 (&acc)[2][2][4][2], const Unit& u, int wr, int wc, int fr, int fq) const {
        const int kind = u.pn >> 2, sub = u.pn & 3;
        if (kind == 4) { store_tile_bf16(acc, u, wr, wc, fr, fq, sub == 0 ? MQ : MZ, 256, 0, false, 0, 0, 0, nullptr, 0); return; }
        bf16_t* base = kind == 0 ? Q : (kind == 1 ? K : (kind == 2 ? VT : Z));
        store_tile_bf16(acc, u, wr, wc, fr, fq, base, 1024, sub * 256, false, 0, 0, 0, nullptr, 0);
    }
};
struct EpiMKV {
    static constexpr bool PERM = true, AFTER_DRAIN = false;
    bf16_t *MKV;
    __device__ __forceinline__ void operator()(const f32x4 (&acc)[2][2][4][2], const Unit& u, int wr, int wc, int fr, int fq) const {
        store_tile_bf16(acc, u, wr, wc, fr, fq, MKV, 512, u.pn * 256, false, 0, 0, 0, nullptr, 0);
    }
};
struct EpiG3 {
    static constexpr bool PERM = true, AFTER_DRAIN = false;
    bf16_t *Q, *K, *V, *Z, *HALO;
    __device__ __forceinline__ void operator()(const f32x4 (&acc)[2][2][4][2], const Unit& u, int wr, int wc, int fr, int fq) const {
        const int kind = u.pn >> 2, sub = u.pn & 3;
        bf16_t* base = kind == 0 ? Q : (kind == 1 ? K : (kind == 2 ? V : Z));
        store_tile_bf16(acc, u, wr, wc, fr, fq, base, 1024, sub * 256, false, 0, 0, 0, kind < 3 ? HALO : nullptr, u.pn * 256);
    }
};
struct EpiGate {
    static constexpr bool PERM = true, AFTER_DRAIN = false;
    bf16_t* Gs; int ldc;
    __device__ __forceinline__ void operator()(const f32x4 (&acc)[2][2][4][2], const Unit& u, int wr, int wc, int fr, int fq) const {
        const int row0 = u.pm * BM + wr * 64 + fr, col0 = u.pn * BM + wc * 32 + 8 * fq;
#pragma unroll
        for (int ai = 0; ai < 2; ++ai)
#pragma unroll
            for (int m = 0; m < 4; ++m)
#pragma unroll
                for (int bj = 0; bj < 2; ++bj) { f32x4 v0 = acc[ai][bj][m][0], v1 = acc[ai][bj][m][1];
#pragma unroll
                    for (int e = 0; e < 4; ++e) { v0[e] = 1.0f / (1.0f + __expf(-v0[e])); v1[e] = 1.0f / (1.0f + __expf(-v1[e])); }
                    *(u32x4*)(Gs + (size_t)(row0 + ai * HALF + m * 16) * ldc + col0 + bj * HALF) = pack8(v0, v1); }
    }
};
template <int MODE> struct EpiMerge {
    static constexpr bool PERM = true, AFTER_DRAIN = false;
    const bf16_t* Gs; float* Ms; bf16_t* Out; int ldc;
    __device__ __forceinline__ void operator()(const f32x4 (&acc)[2][2][4][2], const Unit& u, int wr, int wc, int fr, int fq) const {
        const int row0 = u.pm * BM + wr * 64 + fr, col0 = u.pn * BM + wc * 32 + 8 * fq;
#pragma unroll
        for (int ai = 0; ai < 2; ++ai)
#pragma unroll
            for (int m = 0; m < 4; ++m)
#pragma unroll
                for (int bj = 0; bj < 2; ++bj) { const size_t off = (size_t)(row0 + ai * HALF + m * 16) * ldc + col0 + bj * HALF;
                    const u32x4 g = *(const u32x4*)(Gs + off); f32x4 v0 = acc[ai][bj][m][0], v1 = acc[ai][bj][m][1];
                    f32x4 g0, g1; g0[0] = __builtin_bit_cast(float, g.x << 16); g0[1] = __builtin_bit_cast(float, g.x & 0xffff0000u); g0[2] = __builtin_bit_cast(float, g.y << 16); g0[3] = __builtin_bit_cast(float, g.y & 0xffff0000u);
                    g1[0] = __builtin_bit_cast(float, g.z << 16); g1[1] = __builtin_bit_cast(float, g.z & 0xffff0000u); g1[2] = __builtin_bit_cast(float, g.w << 16); g1[3] = __builtin_bit_cast(float, g.w & 0xffff0000u);
                    v0 = v0 * g0; v1 = v1 * g1;
                    if (MODE == 1 || MODE == 2) { v0 += *(const f32x4*)(Ms + off); v1 += *(const f32x4*)(Ms + off + 4); }
                    if (MODE == 0 || MODE == 1) { *(f32x4*)(Ms + off) = v0; *(f32x4*)(Ms + off + 4) = v1; }
                    else *(u32x4*)(Out + off) = pack8(v0, v1); }
    }
};
struct EpiResid {
    static constexpr bool PERM = false, AFTER_DRAIN = false;
    const float* X; float* Y; int ldc;
    __device__ __forceinline__ void operator()(const f32x4 (&acc)[2][2][4][2], const Unit& u, int wr, int wc, int fr, int fq) const {
        const int row0 = u.pm * BM + wr * 64 + fr, col0 = u.pn * BM + wc * 32 + 4 * fq;
#pragma unroll
        for (int ai = 0; ai < 2; ++ai)
#pragma unroll
            for (int m = 0; m < 4; ++m) { const size_t ro = (size_t)(row0 + ai * HALF + m * 16) * ldc + col0;
#pragma unroll
                for (int bj = 0; bj < 2; ++bj)
#pragma unroll
                    for (int n = 0; n < 2; ++n) { const size_t off = ro + bj * HALF + n * 16; *(f32x4*)(Y + off) = acc[ai][bj][m][n] + *(const f32x4*)(X + off); } }
    }
};
}

#ifndef MK_N_LAUNCHES
#define MK_N_LAUNCHES 1
#endif
constexpr int NWAVES = 8, NTHR = NWAVES * 64;
constexpr int BATCH = 8, SEQ = 2048, DM = 1024, M = BATCH * SEQ;
constexpr int MEM_LEN = 256, MROWS = BATCH * MEM_LEN;
constexpr int IN_WIDTH = 11792;
constexpr int C_DNQKV = 0, C_DNZ = 3072, C_DNB = 4096, C_DNA = 4104, C_SBQKV = 4112, C_SBZ = 7184, C_MQ = 8208, C_MZ = 8464, C_GATE = 8720;
constexpr int N1 = 4608, N3 = 4096, NG = 3072;
constexpr float NORM_EPS = 1e-6f;
constexpr int NHEAD = 8, DH = 128, CH = 64, NCH = SEQ / CH;
constexpr int MH = 4, MDH = 64;

constexpr size_t MiB = 1u << 20;
constexpr size_t WS_CTL = 0, CTL_ZERO_BYTES = 1 * MiB;
constexpr size_t WS_W1T = 1 * MiB, WS_W3T = 10 * MiB, WS_WGT = 18 * MiB, WS_WMKVT = 24 * MiB, WS_WBDN = 25 * MiB, WS_WBSB = 27 * MiB, WS_WBM = 29 * MiB, WS_WOUT = 30 * MiB;
constexpr size_t WS_HN = 32 * MiB;
constexpr size_t WS_R1 = 64 * MiB, WS_R2 = 96 * MiB, WS_R3 = 128 * MiB, WS_R4 = 160 * MiB, WS_R5 = 192 * MiB;
constexpr size_t WS_BG = 224 * MiB, WS_MEMN = 225 * MiB, WS_MK = 229 * MiB  , WS_HALO = 231 * MiB, WS_DECAY = 236 * MiB, WS_END = 237 * MiB;
constexpr size_t OUT_SBQ = 0, OUT_MQ = 32 * MiB, OUT_MZ = 40 * MiB, OUT_A = 48 * MiB;

constexpr int LDS_BYTES = 147456;
#define LAS __attribute__((address_space(3)))
#define GAS __attribute__((address_space(1)))
typedef unsigned short bf16;
typedef float f32x4 __attribute__((ext_vector_type(4)));
typedef float f32x16 __attribute__((ext_vector_type(16)));
typedef short bf16x8 __attribute__((ext_vector_type(8)));
typedef short s16x4 __attribute__((ext_vector_type(4)));
typedef unsigned u32x4 __attribute__((ext_vector_type(4)));
typedef unsigned u32x2 __attribute__((ext_vector_type(2)));

__device__ __forceinline__ unsigned f2bf(float f) { unsigned u = __builtin_bit_cast(unsigned, f); return (u + 0x7fffu + ((u >> 16) & 1u)) >> 16; }
__device__ __forceinline__ unsigned pk2(float lo, float hi) { return f2bf(lo) | (f2bf(hi) << 16); }
__device__ __forceinline__ float bf2f(unsigned short b) { return __builtin_bit_cast(float, (unsigned)b << 16); }
__device__ __forceinline__ float wave_sum(float v) {
#pragma unroll
    for (int o = 1; o < 64; o <<= 1) v += __shfl_xor(v, o);
    return v;
}
__device__ __forceinline__ int lane_id() { return (int)__builtin_amdgcn_mbcnt_hi(~0u, __builtin_amdgcn_mbcnt_lo(~0u, 0u)); }
__device__ __forceinline__ float sigmoidf_(float x) { return 1.0f / (1.0f + __expf(-x)); }
__device__ __forceinline__ float siluf_(float x) { return x / (1.0f + __expf(-x)); }

struct Args { const float* in[15]; float* out; unsigned char* ws; int ph_lo, ph_hi; };
enum { I_X = 0, I_MEM, I_NORMG, I_MEMNORMG, I_WIN, I_CONVW, I_ALOG, I_DTBIAS, I_DNNORMG, I_WMEMKV, I_WBRDN, I_WBRSB, I_WBRMEM, I_WOUT, I_FINALG };
enum { PH_PRO = 0, PH_GEMM1, PH_ATTN, PH_GEMM3, PH_PREP, PH_SCAN, PH_MERGE, PH_OUT, PH_NORM, PH_COUNT };

__device__ __forceinline__ void p0_transpose_item(const float* W, int ldw, int K, int N, bf16* WT, LAS float* scr, int item, int lane) {
    const int nblk = N / 32, kb = item / nblk, nb = item % nblk, k0 = 64 * kb, n0 = 32 * nb;
#pragma unroll 8
    for (int i = 0; i < 32; ++i) { const int kk = 2 * i + (lane >> 5); scr[kk * 33 + (lane & 31)] = W[(size_t)(k0 + kk) * ldw + n0 + (lane & 31)]; }
    asm volatile("s_waitcnt lgkmcnt(0)" ::: "memory");
    const int c = lane & 7;
#pragma unroll
    for (int j = 0; j < 4; ++j) { const int n = (lane >> 3) + 8 * j; const LAS float* s = scr + (8 * c) * 33 + n;
        u32x4 o; o.x = pk2(s[0 * 33], s[1 * 33]); o.y = pk2(s[2 * 33], s[3 * 33]); o.z = pk2(s[4 * 33], s[5 * 33]); o.w = pk2(s[6 * 33], s[7 * 33]);
        *(u32x4*)(WT + (size_t)(n0 + n) * K + k0 + 8 * c) = o; }
    asm volatile("s_waitcnt lgkmcnt(0)" ::: "memory");
}
__device__ __forceinline__ void rms_row(const float* xrow, const float* g, int lane, f32x4 (&v)[4]) {
    const f32x4* xr = (const f32x4*)xrow + lane; const f32x4* gr = (const f32x4*)g + lane;
    float s = 0.f;
#pragma unroll
    for (int j = 0; j < 4; ++j) { v[j] = xr[64 * j]; s += (v[j].x * v[j].x + v[j].y * v[j].y) + (v[j].z * v[j].z + v[j].w * v[j].w); }
    const float rs = 1.0f / sqrtf(wave_sum(s) * (1.0f / DM) + NORM_EPS);
#pragma unroll
    for (int j = 0; j < 4; ++j) { const f32x4 gg = gr[64 * j]; v[j] = v[j] * rs * gg; }
}
__device__ __forceinline__ void store_row_bf16(bf16* orow, int lane, const f32x4 (&v)[4]) {
    unsigned long long* o8 = (unsigned long long*)orow + lane;
#pragma unroll
    for (int j = 0; j < 4; ++j) o8[64 * j] = (unsigned long long)pk2(v[j].x, v[j].y) | ((unsigned long long)pk2(v[j].z, v[j].w) << 32);
}
__device__ __forceinline__ void p0_prologue(const Args& a, LAS unsigned char* lds, int vcu, int G, int wave, int lane) {
    unsigned char* ws = a.ws;
    const int gw = vcu * NWAVES + wave, NGW = G * NWAVES;
    {
        LAS float* scr = (LAS float*)(lds + wave * 16384);
        const float* win = a.in[I_WIN];
        const int it1 = 16 * (N1 / 32), it3 = 16 * (N3 / 32), itg = 16 * (NG / 32), itkv = 16 * (512 / 32), itb = 16 * (1024 / 32), itm = 4 * (1024 / 32);
        const int total = it1 + it3 + itg + itkv + 3 * itb + itm;
        for (int it = gw; it < total; it += NGW) {
            int r = it;
            if (r < it1) { p0_transpose_item(win + C_SBQKV, IN_WIDTH, 1024, N1, (bf16*)(ws + WS_W1T), scr, r, lane); continue; } r -= it1;
            if (r < it3) { p0_transpose_item(win + C_DNQKV, IN_WIDTH, 1024, N3, (bf16*)(ws + WS_W3T), scr, r, lane); continue; } r -= it3;
            if (r < itg) { p0_transpose_item(win + C_GATE, IN_WIDTH, 1024, NG, (bf16*)(ws + WS_WGT), scr, r, lane); continue; } r -= itg;
            if (r < itkv) { p0_transpose_item(a.in[I_WMEMKV], 512, 1024, 512, (bf16*)(ws + WS_WMKVT), scr, r, lane); continue; } r -= itkv;
            if (r < itb) { p0_transpose_item(a.in[I_WBRDN], 1024, 1024, 1024, (bf16*)(ws + WS_WBDN), scr, r, lane); continue; } r -= itb;
            if (r < itb) { p0_transpose_item(a.in[I_WBRSB], 1024, 1024, 1024, (bf16*)(ws + WS_WBSB), scr, r, lane); continue; } r -= itb;
            if (r < itb) { p0_transpose_item(a.in[I_WOUT], 1024, 1024, 1024, (bf16*)(ws + WS_WOUT), scr, r, lane); continue; } r -= itb;
            p0_transpose_item(a.in[I_WBRMEM], 1024, 256, 1024, (bf16*)(ws + WS_WBM), scr, r, lane);
        }
    }
    __syncthreads();
    {
        LAS float* wbgT = (LAS float*)lds;
        const float* wsrc = a.in[I_WIN] + C_DNB;
        for (int i = wave * 64 + lane; i < 1024 * 16; i += NTHR) { const int k = i >> 4, c = i & 15; wbgT[c * 1028 + k] = wsrc[(size_t)k * IN_WIDTH + c]; }
    }
    __syncthreads();
    {
        LAS float* wbgT = (LAS float*)lds;
        LAS float* hrow = (LAS float*)(lds + 16 * 1028 * 4 + wave * 4096);
        bf16* HN = (bf16*)(ws + WS_HN); float* BG = (float*)(ws + WS_BG);
        const int c = lane & 15, kq = lane >> 4;
        for (int m = gw; m < M; m += NGW) {
            f32x4 v[4]; rms_row(a.in[I_X] + (size_t)m * DM, a.in[I_NORMG], lane, v);
            store_row_bf16(HN + (size_t)m * DM, lane, v);
#pragma unroll
            for (int j = 0; j < 4; ++j) *(LAS f32x4*)(hrow + 256 * j + 4 * lane) = v[j];
            asm volatile("s_waitcnt lgkmcnt(0)" ::: "memory");
            float acc = 0.f;
#pragma unroll 8
            for (int t = 0; t < 64; ++t) { const f32x4 w = *(const LAS f32x4*)(wbgT + c * 1028 + 256 * kq + 4 * t); const f32x4 h = *(const LAS f32x4*)(hrow + 256 * kq + 4 * t);
                acc += (w.x * h.x + w.y * h.y) + (w.z * h.z + w.w * h.w); }
            acc += __shfl_xor(acc, 16); acc += __shfl_xor(acc, 32);
            if (lane < 16) BG[(size_t)m * 16 + lane] = acc;
            asm volatile("s_waitcnt lgkmcnt(0)" ::: "memory");
        }
        bf16* MEMN = (bf16*)(ws + WS_MEMN);
        for (int m = gw; m < MROWS; m += NGW) { f32x4 v[4]; rms_row(a.in[I_MEM] + (size_t)m * DM, a.in[I_MEMNORMG], lane, v); store_row_bf16(MEMN + (size_t)m * DM, lane, v); }
    }
}
__device__ __forceinline__ void p8_final_norm(const Args& a, const float* src, int vcu, int G, int wave, int lane) {
    const int gw = vcu * NWAVES + wave, NGW = G * NWAVES;
    for (int m = gw; m < M; m += NGW) { f32x4 v[4]; rms_row(src + (size_t)m * DM, a.in[I_FINALG], lane, v);
        f32x4* o = (f32x4*)(a.out + (size_t)m * DM) + lane;
#pragma unroll
        for (int j = 0; j < 4; ++j) o[64 * j] = v[j]; }
}
typedef GAS unsigned gu32;
#define RLX_AGENT __ATOMIC_RELAXED, __HIP_MEMORY_SCOPE_AGENT
#define XB_TMO      128
#define XB_XCNT(j)  (256  + 64 * (j))
#define XB_XSUB(j)  (1280 + 64 * (j))
#define XB_XGEN(j)  (2304 + 64 * (j))
#define XB_TOP      3328
#define XB_TOPGEN   3392
#define XCD_BAR_WORDS 3456
#define XB_SPIN_CAP (1u << 18)

__device__ __forceinline__ unsigned xb_ld(unsigned* p)              { return __hip_atomic_load(p, __ATOMIC_RELAXED, __HIP_MEMORY_SCOPE_AGENT); }
__device__ __forceinline__ unsigned xb_add(unsigned* p, unsigned v) { return __hip_atomic_fetch_add(p, v, __ATOMIC_RELAXED, __HIP_MEMORY_SCOPE_AGENT); }
__device__ __forceinline__ unsigned xb_xcc_id() { return (unsigned)__builtin_amdgcn_s_getreg((3 << 11) | 20) & 0xFu; }
#define XB_SPIN(cond, bar) do { unsigned _sp = 0; while (cond) { __builtin_amdgcn_s_sleep(1); \
    if ((++_sp & 255u) == 0u) { if (xb_ld(&(bar)[XB_TMO])) break; if (_sp > XB_SPIN_CAP) { atomicAdd(&(bar)[XB_TMO], 1u); break; } } } } while (0)

struct XcdBarrier {
    unsigned* bar; unsigned x;
    volatile LAS unsigned* st;
};

__device__ __forceinline__ XcdBarrier xcd_barrier_post(unsigned* bar, volatile LAS unsigned* st, bool leader) {
    XcdBarrier b; b.bar = bar; b.x = xb_xcc_id(); b.st = st;
    if (leader) (void)xb_add(&bar[XB_XCNT(b.x)], 1u);
    return b;
}
__device__ __forceinline__ void xcd_barrier_complete(unsigned* bar, unsigned x, unsigned& nloc, unsigned& nx) {
    const unsigned G = gridDim.x * gridDim.y * gridDim.z;
    unsigned sum, cnt, mine, sp = 0u;
    for (;;) {
        sum = 0u; cnt = 0u; mine = 0u;
#pragma unroll
        for (unsigned j = 0; j < 16; ++j) { const unsigned c = xb_ld(&bar[XB_XCNT(j)]); sum += c; cnt += (c > 0u) ? 1u : 0u; mine = (j == x) ? c : mine; }
        if (sum == G) break;
        __builtin_amdgcn_s_sleep(1);
        if ((++sp & 255u) == 0u) { if (xb_ld(&bar[XB_TMO])) break; if (sp > XB_SPIN_CAP) { atomicAdd(&bar[XB_TMO], 1u); break; } }
    }
    nloc = mine > 0u ? mine : 1u; nx = cnt > 0u ? cnt : 1u;
}

__device__ __forceinline__ void xcd_barrier(const XcdBarrier& b, bool leader  ) {
    asm volatile("s_waitcnt vmcnt(0)" ::: "memory");
    __syncthreads();
    if (leader) {
        unsigned* bar = b.bar;
        __builtin_amdgcn_s_waitcnt(0);
        unsigned nloc = b.st[0], nx = b.st[1];
        if (nloc == 0u) { xcd_barrier_complete(bar, b.x, nloc, nx); b.st[0] = nloc; b.st[1] = nx; }
        const unsigned old = xb_add(&bar[XB_XSUB(b.x)], 1u);
        const unsigned gen = old / nloc;
        if (old + 1u == (gen + 1u) * nloc) {
            __builtin_amdgcn_fence(__ATOMIC_RELEASE, "agent");
            asm volatile("s_waitcnt vmcnt(0)" ::: "memory");
            const unsigned og = xb_add(&bar[XB_TOP], 1u);
            const unsigned tg = og / nx;
            if (og + 1u == (tg + 1u) * nx) xb_add(&bar[XB_TOPGEN], 1u);
            else XB_SPIN(xb_ld(&bar[XB_TOPGEN]) == tg, bar);
            __builtin_amdgcn_fence(__ATOMIC_ACQUIRE, "agent");
            xb_add(&bar[XB_XGEN(b.x)], 1u);
            asm volatile("s_waitcnt vmcnt(0)" ::: "memory");
        } else {
            XB_SPIN(xb_ld(&bar[XB_XGEN(b.x)]) == gen, bar);
            __builtin_amdgcn_fence(__ATOMIC_ACQUIRE, "agent");
            asm volatile("s_waitcnt vmcnt(0)" ::: "memory");
        }
    }
    __syncthreads();
}

#define MFMA32(a, b, c) __builtin_amdgcn_mfma_f32_32x32x16_bf16((a), (b), (c), 0, 0, 0)
__device__ __forceinline__ int crow(int r, int h) { return (r & 3) + 8 * (r >> 2) + 4 * h; }
__device__ __forceinline__ bf16x8 ldsfrag(const LAS bf16* p) { return *(const LAS bf16x8*)p; }
__device__ __forceinline__ f32x16 zero16() { f32x16 z;
#pragma unroll
    for (int i = 0; i < 16; ++i) z[i] = 0.f; return z; }
#define LDS_WAIT() asm volatile("s_waitcnt lgkmcnt(0)" ::: "memory")

__device__ __forceinline__ void mem_attn_unit(const Args& a, LAS unsigned char* lds, int u, int wave, int lane) {
    const int b = u >> 5, hm = (u >> 3) & 3, tb = u & 7, tid = wave * 64 + lane;
    const bf16* MKV = (const bf16*)(a.ws + WS_MK);
    bf16* MQ = (bf16*)((unsigned char*)a.out + OUT_MQ); const bf16* MZ = (const bf16*)((unsigned char*)a.out + OUT_MZ);
    LAS bf16* MKs = (LAS bf16*)lds;
    LAS bf16* MVTs = (LAS bf16*)(lds + 36864);
    LAS bf16* Pw = (LAS bf16*)(lds + 36864 + 33792 + wave * 4608);
    __syncthreads();
    for (int i = tid; i < 2048; i += NTHR) { const int r = i >> 3, c = i & 7; *(LAS u32x4*)(MKs + r * 72 + c * 8) = *(const u32x4*)(MKV + (size_t)(b * 256 + r) * 512 + hm * 64 + c * 8); }
    for (int i = tid; i < 2048; i += NTHR) { const int m = i & 255, c = i >> 8; const u32x4 v = *(const u32x4*)(MKV + (size_t)(b * 256 + m) * 512 + 256 + hm * 64 + c * 8);
        const unsigned w4[4] = {v.x, v.y, v.z, v.w};
#pragma unroll
        for (int e = 0; e < 8; ++e) MVTs[(c * 8 + e) * 264 + m] = (bf16)(w4[e >> 1] >> ((e & 1) * 16)); }
    __syncthreads();
    const int r32 = lane & 31, hh = lane >> 5;
    const size_t row0 = (size_t)b * SEQ + tb * 256 + wave * 32;
    bf16x8 qf[4];
#pragma unroll
    for (int ks = 0; ks < 4; ++ks) qf[ks] = *(const bf16x8*)(MQ + (row0 + r32) * 256 + hm * 64 + 16 * ks + 8 * hh);
    f32x16 p[8];
#pragma unroll
    for (int mt = 0; mt < 8; ++mt) { p[mt] = zero16();
#pragma unroll
        for (int ks = 0; ks < 4; ++ks) p[mt] = MFMA32(ldsfrag(MKs + (32 * mt + r32) * 72 + 16 * ks + 8 * hh), qf[ks], p[mt]); }
    float mx = -3.0e38f;
#pragma unroll
    for (int mt = 0; mt < 8; ++mt)
#pragma unroll
        for (int r = 0; r < 16; ++r) mx = fmaxf(mx, p[mt][r]);
    mx = fmaxf(mx, __shfl_xor(mx, 32));
    float sum = 0.f;
#pragma unroll
    for (int mt = 0; mt < 8; ++mt)
#pragma unroll
        for (int r = 0; r < 16; ++r) { const float e = __expf((p[mt][r] - mx) * 0.125f); p[mt][r] = e; sum += e; }
    sum += __shfl_xor(sum, 32);
    const float inv = 1.0f / sum;
    f32x16 o[2]; o[0] = zero16(); o[1] = zero16();
#pragma unroll
    for (int c = 0; c < 4; ++c) {
#pragma unroll
        for (int k2 = 0; k2 < 2; ++k2)
#pragma unroll
            for (int g = 0; g < 4; ++g) { const f32x16& pp = p[2 * c + k2]; u32x2 w; w.x = pk2(pp[4 * g] * inv, pp[4 * g + 1] * inv); w.y = pk2(pp[4 * g + 2] * inv, pp[4 * g + 3] * inv);
                *(LAS u32x2*)(Pw + r32 * 72 + 32 * k2 + 8 * g + 4 * hh) = w; }
        LDS_WAIT();
#pragma unroll
        for (int ks = 0; ks < 4; ++ks) { const bf16x8 pa = ldsfrag(Pw + r32 * 72 + 16 * ks + 8 * hh);
#pragma unroll
            for (int dt = 0; dt < 2; ++dt) o[dt] = MFMA32(pa, ldsfrag(MVTs + (32 * dt + r32) * 264 + 64 * c + 16 * ks + 8 * hh), o[dt]); }
        LDS_WAIT();
    }
#pragma unroll
    for (int dt = 0; dt < 2; ++dt)
#pragma unroll
        for (int r = 0; r < 16; ++r) { const size_t off = (row0 + crow(r, hh)) * 256 + hm * 64 + 32 * dt + r32; MQ[off] = (bf16)f2bf(o[dt][r] * siluf_(bf2f(MZ[off]))); }
}

__device__ __forceinline__ void sb_attn_unit(const Args& a, LAS unsigned char* lds, int b, int h, int qb, int wave, int lane) {
    const bf16* K = (const bf16*)(a.ws + WS_R1); const bf16* V = (const bf16*)(a.ws + WS_R2); const bf16* Z = (const bf16*)(a.ws + WS_R3);
    bf16* Q = (bf16*)((unsigned char*)a.out + OUT_SBQ);
    LAS bf16* Ks = (LAS bf16*)lds;
    LAS bf16* VTs = (LAS bf16*)(lds + 17408);
    LAS bf16* Pw = (LAS bf16*)(lds + 35840 + wave * 4608);
    const int r32 = lane & 31, hh = lane >> 5, tid = wave * 64 + lane;
    const int tq0 = 256 * qb + 32 * wave, tq = tq0 + r32;
    const size_t rowb = (size_t)b * SEQ;
    bf16x8 qf[8];
#pragma unroll
    for (int ks = 0; ks < 8; ++ks) qf[ks] = *(const bf16x8*)(Q + (rowb + tq) * 1024 + h * 128 + 16 * ks + 8 * hh);
    f32x16 o[4];
#pragma unroll
    for (int dt = 0; dt < 4; ++dt) o[dt] = zero16();
    float carry = 0.f;
    const float scale = 0.08838834764831845f;
    for (int kt = 4 * qb + 3; kt >= 0; --kt) {
        __syncthreads();
        for (int i = tid; i < 1024; i += NTHR) { const int r = i >> 4, c = i & 15; *(LAS u32x4*)(Ks + r * 136 + c * 8) = *(const u32x4*)(K + (rowb + 64 * kt + r) * 1024 + h * 128 + c * 8); }
        for (int i = tid; i < 1024; i += NTHR) { const int r = i & 63, c = i >> 6; const u32x4 v = *(const u32x4*)(V + (rowb + 64 * kt + r) * 1024 + h * 128 + c * 8);
            const unsigned w4[4] = {v.x, v.y, v.z, v.w};
#pragma unroll
            for (int e = 0; e < 8; ++e) VTs[(c * 8 + e) * 72 + r] = (bf16)(w4[e >> 1] >> ((e & 1) * 16)); }
        __syncthreads();
        if (64 * kt >= tq0 + 31) continue;
        f32x16 p[2]; p[0] = zero16(); p[1] = zero16();
#pragma unroll
        for (int ks = 0; ks < 8; ++ks) { p[0] = MFMA32(ldsfrag(Ks + r32 * 136 + 16 * ks + 8 * hh), qf[ks], p[0]); p[1] = MFMA32(ldsfrag(Ks + (32 + r32) * 136 + 16 * ks + 8 * hh), qf[ks], p[1]); }
        f32x16 lf[2];
        float gs[2][4];
#pragma unroll
        for (int k = 0; k < 2; ++k)
#pragma unroll
            for (int g = 0; g < 4; ++g) { float s4 = 0.f;
#pragma unroll
                for (int j = 0; j < 4; ++j) { const int r = 4 * g + j; const float z = p[k][r] * scale; const float l1p = __logf(1.0f + __expf(-fabsf(z)));
                    const bool causal = (64 * kt + 32 * k + crow(r, hh)) < tq;
                    const float lbv = fminf(z, 0.f) - l1p, lfv = causal ? (fminf(-z, 0.f) - l1p) : 0.f;
                    p[k][r] = causal ? lbv : -1.0e30f; lf[k][r] = lfv; s4 += lfv; }
                gs[k][g] = s4; }
        float run = carry;
#pragma unroll
        for (int k = 1; k >= 0; --k)
#pragma unroll
            for (int g = 3; g >= 0; --g) { const float other = __shfl_xor(gs[k][g], 32);
                const float g_hi = hh ? gs[k][g] : other, g_lo = hh ? other : gs[k][g];
                float sv = hh ? run : run + g_hi;
                run += g_hi + g_lo;
#pragma unroll
                for (int j = 3; j >= 0; --j) { const int r = 4 * g + j; const float att = __expf(p[k][r] + sv); sv += lf[k][r]; p[k][r] = att; } }
        carry = run;
#pragma unroll
        for (int k = 0; k < 2; ++k)
#pragma unroll
            for (int g = 0; g < 4; ++g) { u32x2 w; w.x = pk2(p[k][4 * g], p[k][4 * g + 1]); w.y = pk2(p[k][4 * g + 2], p[k][4 * g + 3]); *(LAS u32x2*)(Pw + r32 * 72 + 32 * k + 8 * g + 4 * hh) = w; }
        LDS_WAIT();
#pragma unroll
        for (int ks = 0; ks < 4; ++ks) { const bf16x8 pa = ldsfrag(Pw + r32 * 72 + 16 * ks + 8 * hh);
#pragma unroll
            for (int dt = 0; dt < 4; ++dt) o[dt] = MFMA32(pa, ldsfrag(VTs + (32 * dt + r32) * 72 + 16 * ks + 8 * hh), o[dt]); }
        LDS_WAIT();
    }
#pragma unroll
    for (int dt = 0; dt < 4; ++dt)
#pragma unroll
        for (int r = 0; r < 16; ++r) { const size_t off = (rowb + tq0 + crow(r, hh)) * 1024 + h * 128 + 32 * dt + r32; Q[off] = (bf16)f2bf(o[dt][r] * siluf_(bf2f(Z[off]))); }
}
__device__ __forceinline__ void p2_attention(const Args& a, LAS unsigned char* lds, int vcu, int G, int wave, int lane) {
    for (int u = vcu; u < 256; u += G) mem_attn_unit(a, lds, u, wave, lane);
    for (int u = vcu; u < 512; u += G) { const int v = u & 255, bh = v >> 2, j = v & 3; sb_attn_unit(a, lds, bh >> 3, bh & 7, u < 256 ? j : 7 - j, wave, lane); }
    __syncthreads();
}
template <int I> struct SolveRows {
    static __device__ __forceinline__ void run(float (&Tc)[64], const LAS float* MT, int lane) {
        float acc[4] = {(I == lane) ? 1.f : 0.f, 0.f, 0.f, 0.f};
#pragma unroll
        for (int j4 = 0; j4 < (I + 3) / 4; ++j4) { const f32x4 m = *(const LAS f32x4*)(MT + I * 68 + 4 * j4);
            acc[0] -= m.x * Tc[4 * j4];
            if (4 * j4 + 1 < I) acc[1] -= m.y * Tc[4 * j4 + 1];
            if (4 * j4 + 2 < I) acc[2] -= m.z * Tc[4 * j4 + 2];
            if (4 * j4 + 3 < I) acc[3] -= m.w * Tc[4 * j4 + 3]; }
        Tc[I] = (acc[0] + acc[1]) + (acc[2] + acc[3]);
        asm volatile("" ::: "memory");
        SolveRows<I + 1>::run(Tc, MT, lane);
    }
};
template <> struct SolveRows<64> { static __device__ __forceinline__ void run(float (&)[64], const LAS float*, int) {} };
__device__ __forceinline__ void dn_prep_item(const Args& a, LAS unsigned char* lds, int item, int wave, int lane) {
    asm volatile("" : "+v"(lane));
    const int b = item >> 8, h = (item >> 5) & 7, n = item & 31; int tid = wave * 64 + lane;
    const size_t rowb = (size_t)b * SEQ + n * CH;
    bf16* R1 = (bf16*)(a.ws + WS_R1); bf16* R2 = (bf16*)(a.ws + WS_R2); bf16* R3 = (bf16*)(a.ws + WS_R3); bf16* R5 = (bf16*)(a.ws + WS_R5);
    const bf16* HALO = (const bf16*)(a.ws + WS_HALO); const float* BG = (const float*)(a.ws + WS_BG);
    bf16* AO = (bf16*)((unsigned char*)a.out + OUT_A) + (size_t)item * 4096;
    LAS bf16* QS = (LAS bf16*)lds;
    LAS bf16* KS = (LAS bf16*)(lds + 17408);
    LAS bf16* KBT = (LAS bf16*)(lds + 34816);
    LAS bf16* VBT = (LAS bf16*)(lds + 53248);
    LAS float* MT = (LAS float*)(lds + 71680);
    LAS bf16* TB = (LAS bf16*)(lds + 89088);
    LAS float* GL = (LAS float*)(lds + 98304);
    LAS float* BL = GL + 64;
    __syncthreads();
    if (wave == 0) {
        const float bb = BG[(rowb + lane) * 16 + h], aa = BG[(rowb + lane) * 16 + 8 + h];
        const float x = aa + a.in[I_DTBIAS][h];
        const float sp = fmaxf(x, 0.f) + log1pf(expf(-fabsf(x)));
        float g = -expf(a.in[I_ALOG][h]) * sp;
#pragma unroll
        for (int o = 1; o < 64; o <<= 1) { const float t = __shfl_up(g, o); if (lane >= o) g += t; }
        GL[lane] = g; BL[lane] = 1.0f / (1.0f + expf(-bb));
    }
    __syncthreads();
    {
        const int cc = tid & 15, rg = tid >> 4, r0 = 2 * rg;
        const float* cw = a.in[I_CONVW];
#pragma unroll 1
        for (int ten = 0; ten < 3; ++ten) {
            const bf16* src = ten == 0 ? R1 : (ten == 1 ? R2 : R3);
            const int gcol = h * 128 + cc * 8;
            float x[5][8];
#pragma unroll
            for (int j = 0; j < 5; ++j) { const int r = r0 - 3 + j; u32x4 v;
                if (r >= 0) v = *(const u32x4*)(src + (rowb + r) * 1024 + gcol);
                else if (n > 0) v = *(const u32x4*)(HALO + (size_t)((b * NCH + n - 1) * 3 + (r + 3)) * 3072 + ten * 1024 + gcol);
                else v = (u32x4){0u, 0u, 0u, 0u};
                const unsigned w4[4] = {v.x, v.y, v.z, v.w};
#pragma unroll
                for (int e = 0; e < 8; ++e) x[j][e] = __builtin_bit_cast(float, (w4[e >> 1] >> ((e & 1) * 16)) << 16); }
            float wq[4][8];
#pragma unroll
            for (int j = 0; j < 4; ++j) { const f32x4 w0 = *(const f32x4*)(cw + j * 3072 + ten * 1024 + gcol), w1 = *(const f32x4*)(cw + j * 3072 + ten * 1024 + gcol + 4);
                wq[j][0] = w0.x; wq[j][1] = w0.y; wq[j][2] = w0.z; wq[j][3] = w0.w; wq[j][4] = w1.x; wq[j][5] = w1.y; wq[j][6] = w1.z; wq[j][7] = w1.w; }
#pragma unroll
            for (int rr = 0; rr < 2; ++rr) { const int r = r0 + rr; float y[8]; float ss = 0.f;
#pragma unroll
                for (int e = 0; e < 8; ++e) { float s = 0.f;
#pragma unroll
                    for (int j = 0; j < 4; ++j) s += wq[j][e] * x[rr + j][e];
                    y[e] = s / (1.0f + __expf(-s)); ss += y[e] * y[e]; }
                if (ten < 2) { ss += __shfl_xor(ss, 1); ss += __shfl_xor(ss, 2); ss += __shfl_xor(ss, 4); ss += __shfl_xor(ss, 8);
                    const float sc = (1.0f / sqrtf(ss + NORM_EPS)) * (ten == 0 ? 0.08838834764831845f : 1.0f);
#pragma unroll
                    for (int e = 0; e < 8; ++e) y[e] *= sc;
                    u32x4 w; w.x = pk2(y[0], y[1]); w.y = pk2(y[2], y[3]); w.z = pk2(y[4], y[5]); w.w = pk2(y[6], y[7]);
                    *(LAS u32x4*)((ten == 0 ? QS : KS) + r * 136 + cc * 8) = w;
                    if (ten == 1) { const float f = BL[r] * __expf(GL[r]);
#pragma unroll
                        for (int e = 0; e < 8; ++e) KBT[(cc * 8 + e) * 72 + r] = (bf16)f2bf(y[e] * f); }
                } else { const float f = BL[r];
#pragma unroll
                    for (int e = 0; e < 8; ++e) VBT[(cc * 8 + e) * 72 + r] = (bf16)f2bf(y[e] * f); } }
        }
    }
    __syncthreads();
    int r32 = lane & 31, hh = lane >> 5;
    {
        const int which = wave >> 2, ti = (wave >> 1) & 1, tj = wave & 1;
        const LAS bf16* X = which ? QS : KS;
        f32x16 c = zero16();
#pragma unroll
        for (int ks = 0; ks < 8; ++ks) c = MFMA32(ldsfrag(X + (32 * ti + r32) * 136 + 16 * ks + 8 * hh), ldsfrag(KS + (32 * tj + r32) * 136 + 16 * ks + 8 * hh), c);
        const int j = 32 * tj + r32; const float Gj = GL[j];
#pragma unroll
        for (int r = 0; r < 16; ++r) { const int i = 32 * ti + crow(r, hh); const float Gi = GL[i];
            if (which == 0) MT[i * 68 + j] = (i > j) ? BL[i] * c[r] * __expf(Gi - Gj) : 0.f;
            else AO[i * 64 + j] = (bf16)f2bf((i >= j) ? c[r] * __expf(Gi - Gj) : 0.f); }
    }
    __syncthreads();
    if (wave == 0) {
        float Tc[64];
        SolveRows<0>::run(Tc, MT, lane);
#pragma unroll
        for (int i = 0; i < 64; ++i) TB[i * 72 + lane] = (bf16)f2bf(Tc[i]);
    }
    __syncthreads();
    asm volatile("" : "+v"(lane)); r32 = lane & 31; hh = lane >> 5; tid = wave * 64 + lane;
    {
        { const int ei = wave >> 1, cj = wave & 1; f32x16 c = zero16();
#pragma unroll
          for (int ks = 0; ks < 4; ++ks) c = MFMA32(ldsfrag(VBT + (32 * ei + r32) * 72 + 16 * ks + 8 * hh), ldsfrag(TB + (32 * cj + r32) * 72 + 16 * ks + 8 * hh), c);
#pragma unroll
          for (int r = 0; r < 16; ++r) { const int e = 32 * ei + crow(r, hh), cidx = 32 * cj + r32; R3[(rowb + (e >> 1)) * 1024 + h * 128 + (e & 1) * 64 + cidx] = (bf16)f2bf(c[r]); } }
        { const int ci = wave >> 2, dj = wave & 3; f32x16 c = zero16();
#pragma unroll
          for (int ks = 0; ks < 4; ++ks) c = MFMA32(ldsfrag(TB + (32 * ci + r32) * 72 + 16 * ks + 8 * hh), ldsfrag(KBT + (32 * dj + r32) * 72 + 16 * ks + 8 * hh), c);
#pragma unroll
          for (int r = 0; r < 16; ++r) { const int cidx = 32 * ci + crow(r, hh), d = 32 * dj + r32; R2[(rowb + cidx) * 1024 + h * 128 + d] = (bf16)f2bf(c[r]); } }
    }
    {
        const float Glast = GL[63];
        for (int i = tid; i < 1024; i += NTHR) { const int r = i >> 4, c8 = i & 15; const float f = __expf(GL[r]);
            const u32x4 v = *(const LAS u32x4*)(QS + r * 136 + c8 * 8); const unsigned w4[4] = {v.x, v.y, v.z, v.w}; float y[8];
#pragma unroll
            for (int e = 0; e < 8; ++e) y[e] = __builtin_bit_cast(float, (w4[e >> 1] >> ((e & 1) * 16)) << 16) * f;
            u32x4 w; w.x = pk2(y[0], y[1]); w.y = pk2(y[2], y[3]); w.z = pk2(y[4], y[5]); w.w = pk2(y[6], y[7]);
            *(u32x4*)(R1 + (rowb + r) * 1024 + h * 128 + c8 * 8) = w; }
        for (int i = tid; i < 1024; i += NTHR) { const int d = i & 127, c8 = i >> 7; float y[8];
#pragma unroll
            for (int e = 0; e < 8; ++e) { const int c = c8 * 8 + e; y[e] = bf2f(KS[c * 136 + d]) * __expf(Glast - GL[c]); }
            u32x4 w; w.x = pk2(y[0], y[1]); w.y = pk2(y[2], y[3]); w.z = pk2(y[4], y[5]); w.w = pk2(y[6], y[7]);
            *(u32x4*)(R5 + (rowb + (d >> 1)) * 1024 + h * 128 + (d & 1) * 64 + c8 * 8) = w; }
        if (tid == 0) ((float*)(a.ws + WS_DECAY))[item] = __expf(Glast);
    }
}

__device__ __forceinline__ void dn_scan_unit(const Args& a, LAS unsigned char* lds, int bh, int wave, int lane) {
    const int b = bh >> 3, h = bh & 7;
    const bf16* R1 = (const bf16*)(a.ws + WS_R1); const bf16* R2 = (const bf16*)(a.ws + WS_R2); const bf16* R3 = (const bf16*)(a.ws + WS_R3); const bf16* R5 = (const bf16*)(a.ws + WS_R5);
    bf16* R4 = (bf16*)(a.ws + WS_R4);
    const float* DEC = (const float*)(a.ws + WS_DECAY);
    LAS bf16* Wl = (LAS bf16*)lds;
    LAS bf16* QDl = (LAS bf16*)(lds + 17408);
    LAS bf16* Al = (LAS bf16*)(lds + 34816);
    LAS bf16* KDTl = (LAS bf16*)(lds + 44032);
    LAS bf16* UTl = (LAS bf16*)(lds + 62464);
    LAS bf16* STB = (LAS bf16*)(lds + 80896);
    LAS bf16* VN = (LAS bf16*)(lds + 115712);
    LAS float* SSQ = (LAS float*)(lds + 134144);
    int r32 = lane & 31, hh = lane >> 5, tid = wave * 64 + lane; const int e0 = 32 * wave;
    f32x16 S[4];
#pragma unroll
    for (int dj = 0; dj < 4; ++dj) S[dj] = zero16();
    __syncthreads();
    for (int i = tid; i < 128 * 136 / 2; i += NTHR) ((LAS unsigned*)STB)[i] = 0u;
    for (int n = 0; n < NCH; ++n) {
        asm volatile("" : "+v"(lane)); r32 = lane & 31; hh = lane >> 5; tid = wave * 64 + lane;
        const size_t rowb = (size_t)b * SEQ + n * CH; const int item = (b * 8 + h) * NCH + n;
        const bf16* AO = (const bf16*)((const unsigned char*)a.out + OUT_A) + (size_t)item * 4096;
        __syncthreads();
        for (int i = tid; i < 1024; i += NTHR) { const int r = i >> 4, c8 = i & 15;
            *(LAS u32x4*)(Wl + r * 136 + c8 * 8) = *(const u32x4*)(R2 + (rowb + r) * 1024 + h * 128 + c8 * 8);
            *(LAS u32x4*)(QDl + r * 136 + c8 * 8) = *(const u32x4*)(R1 + (rowb + r) * 1024 + h * 128 + c8 * 8); }
        for (int i = tid; i < 1024; i += NTHR) { const int e = i >> 3, c8 = i & 7; const size_t g = (rowb + (e >> 1)) * 1024 + h * 128 + (e & 1) * 64 + c8 * 8;
            *(LAS u32x4*)(UTl + e * 72 + c8 * 8) = *(const u32x4*)(R3 + g);
            *(LAS u32x4*)(KDTl + e * 72 + c8 * 8) = *(const u32x4*)(R5 + g); }
        for (int i = tid; i < 512; i += NTHR) { const int r = i >> 3, c8 = i & 7; *(LAS u32x4*)(Al + r * 72 + c8 * 8) = *(const u32x4*)(AO + r * 64 + c8 * 8); }
        const float decay = DEC[item];
        __syncthreads();
        f32x16 oT[2];
        if (wave < 4) {
#pragma unroll
            for (int cj = 0; cj < 2; ++cj) { f32x16 c = zero16();
#pragma unroll
                for (int ks = 0; ks < 8; ++ks) c = MFMA32(ldsfrag(STB + (e0 + r32) * 136 + 16 * ks + 8 * hh), ldsfrag(Wl + (32 * cj + r32) * 136 + 16 * ks + 8 * hh), c);
#pragma unroll
                for (int r = 0; r < 16; ++r) { const int e = e0 + crow(r, hh), cidx = 32 * cj + r32; VN[e * 72 + cidx] = (bf16)f2bf(bf2f(UTl[e * 72 + cidx]) - c[r]); } }
            LDS_WAIT();
#pragma unroll
            for (int ci = 0; ci < 2; ++ci) { f32x16 c = zero16();
#pragma unroll
                for (int ks = 0; ks < 8; ++ks) c = MFMA32(ldsfrag(STB + (e0 + r32) * 136 + 16 * ks + 8 * hh), ldsfrag(QDl + (32 * ci + r32) * 136 + 16 * ks + 8 * hh), c);
#pragma unroll
                for (int ks = 0; ks < 4; ++ks) c = MFMA32(ldsfrag(VN + (e0 + r32) * 72 + 16 * ks + 8 * hh), ldsfrag(Al + (32 * ci + r32) * 72 + 16 * ks + 8 * hh), c);
                oT[ci] = c; }
#pragma unroll
            for (int dj = 0; dj < 4; ++dj) { f32x16 c = S[dj] * decay;
#pragma unroll
                for (int ks = 0; ks < 4; ++ks) c = MFMA32(ldsfrag(VN + (e0 + r32) * 72 + 16 * ks + 8 * hh), ldsfrag(KDTl + (32 * dj + r32) * 72 + 16 * ks + 8 * hh), c);
                S[dj] = c; }
            LDS_WAIT();
#pragma unroll
            for (int dj = 0; dj < 4; ++dj)
#pragma unroll
                for (int r = 0; r < 16; ++r) STB[(e0 + crow(r, hh)) * 136 + 32 * dj + r32] = (bf16)f2bf(S[dj][r]);
#pragma unroll
            for (int ci = 0; ci < 2; ++ci) { float s = 0.f;
#pragma unroll
                for (int r = 0; r < 16; ++r) s += oT[ci][r] * oT[ci][r];
                s += __shfl_xor(s, 32);
                if (hh == 0) SSQ[wave * 64 + 32 * ci + r32] = s; }
        }
        __syncthreads();
        asm volatile("" : "+v"(lane)); r32 = lane & 31; hh = lane >> 5;
        if (wave < 4) {
#pragma unroll
            for (int ci = 0; ci < 2; ++ci) { const int cidx = 32 * ci + r32;
                const float ss = (SSQ[cidx] + SSQ[64 + cidx]) + (SSQ[128 + cidx] + SSQ[192 + cidx]);
                const float rs = 1.0f / sqrtf(ss * (1.0f / 128.0f) + NORM_EPS);
#pragma unroll
                for (int r = 0; r < 16; ++r) { const int e = e0 + crow(r, hh); const size_t off = (rowb + cidx) * 1024 + h * 128 + e;
                    const float z = bf2f(R4[off]); R4[off] = (bf16)f2bf(oT[ci][r] * rs * a.in[I_DNNORMG][e] * (z / (1.0f + __expf(-z)))); } }
        }
    }
    __syncthreads();
}
__global__ void __launch_bounds__(NTHR, 2) hyb_fwd(Args args) {
    extern __shared__ __attribute__((aligned(16))) unsigned char lds_raw[];
    LAS unsigned char* lds = (LAS unsigned char*)lds_raw;
    const int wave = __builtin_amdgcn_readfirstlane((int)threadIdx.x >> 6);
    const int lane = lane_id();
    const int G = gridDim.x, bx = blockIdx.x, vcu = (G % 8 == 0) ? (bx % 8) * (G / 8) + bx / 8 : bx;
    const int lo = args.ph_lo, hi = args.ph_hi;
#define IN(k) (lo <= (k) && (k) < hi)
#if MK_N_LAUNCHES == 1
    volatile LAS unsigned* MISC = (volatile LAS unsigned*)(lds + LDS_BYTES - 256);
    if (wave == 0 && lane < 2) MISC[lane] = 0u;
    __syncthreads();
    const XcdBarrier bar = xcd_barrier_post((unsigned*)(args.ws + WS_CTL) + 4096, MISC, wave == 0 && lane == 0);
#define SEAM(k) do { if (IN(k) && IN((k) + 1)) { if ((k) == PH_PRO) cg::this_grid().sync(); else xcd_barrier(bar, wave == 0 && lane_id() == 0); } } while (0)
#else
#define SEAM(k) do { } while (0)
#endif
    unsigned char* ws = args.ws; unsigned char* ob = (unsigned char*)args.out;
    bf16* HN = (bf16*)(ws + WS_HN);
    if (IN(PH_PRO)) { p0_prologue(args, lds, vcu, G, wave, lane); }
    SEAM(PH_PRO);
    if (IN(PH_GEMM1)) {
        pg8::Gemm g{HN, (const bf16*)(ws + WS_W1T), M, N1, 1024}; pg8::StaticOrder S; S.init(M, N1, G, bx);
        pg8::EpiG1 E{(bf16*)(ob + OUT_SBQ), (bf16*)(ws + WS_R1), (bf16*)(ws + WS_R2), (bf16*)(ws + WS_R3), (bf16*)(ob + OUT_MQ), (bf16*)(ob + OUT_MZ)};
        pg8::gemm_phase<pg8::EpiG1, pg8::StaticOrder, true, true>(lds, g, S, E, wave);
        pg8::Gemm g2{(const bf16*)(ws + WS_MEMN), (const bf16*)(ws + WS_WMKVT), MROWS, 512, 1024}; pg8::StaticOrder S2; S2.init(MROWS, 512, G, G - 1 - bx);
        pg8::EpiMKV E2{(bf16*)(ws + WS_MK)};
        pg8::gemm_phase<pg8::EpiMKV, pg8::StaticOrder, true, true>(lds, g2, S2, E2, wave);
    }
    SEAM(PH_GEMM1);
    if (IN(PH_ATTN)) { p2_attention(args, lds, vcu, G, wave, lane); }
    SEAM(PH_ATTN);
    if (IN(PH_GEMM3)) {
        pg8::Gemm g{HN, (const bf16*)(ws + WS_W3T), M, N3, 1024}; pg8::StaticOrder S; S.init(M, N3, G, bx);
        pg8::EpiG3 E{(bf16*)(ws + WS_R1), (bf16*)(ws + WS_R2), (bf16*)(ws + WS_R3), (bf16*)(ws + WS_R4), (bf16*)(ws + WS_HALO)};
        pg8::gemm_phase<pg8::EpiG3, pg8::StaticOrder, true, true>(lds, g, S, E, wave);
    }
    SEAM(PH_GEMM3);
    if (IN(PH_PREP)) { for (int it = vcu; it < BATCH * NHEAD * NCH; it += G) dn_prep_item(args, lds, it, wave, lane); __syncthreads(); }
    SEAM(PH_PREP);
    if (IN(PH_SCAN)) { for (int u = bx; u < BATCH * NHEAD; u += G) dn_scan_unit(args, lds, u, wave, lane); }
    SEAM(PH_SCAN);
    if (IN(PH_MERGE)) {
        pg8::StaticOrder S; S.init(M, 1024, G, bx);
        bf16* Gs = (bf16*)(ws + WS_R1); float* Ms = (float*)(ws + WS_R2); bf16* MERGED = (bf16*)(ws + WS_R5);
        const bf16* WG = (const bf16*)(ws + WS_WGT);
        { pg8::Gemm g{HN, WG, M, 1024, 1024}; pg8::EpiGate E{Gs, 1024}; pg8::gemm_phase<pg8::EpiGate, pg8::StaticOrder, true, true>(lds, g, S, E, wave); }
        { pg8::Gemm g{(const bf16*)(ws + WS_R4), (const bf16*)(ws + WS_WBDN), M, 1024, 1024}; pg8::EpiMerge<0> E{Gs, Ms, MERGED, 1024}; pg8::gemm_phase<pg8::EpiMerge<0>, pg8::StaticOrder, true, true>(lds, g, S, E, wave); }
        { pg8::Gemm g{HN, WG + (size_t)1 * 1024 * 1024, M, 1024, 1024}; pg8::EpiGate E{Gs, 1024}; pg8::gemm_phase<pg8::EpiGate, pg8::StaticOrder, true, true>(lds, g, S, E, wave); }
        { pg8::Gemm g{(const bf16*)(ob + OUT_SBQ), (const bf16*)(ws + WS_WBSB), M, 1024, 1024}; pg8::EpiMerge<1> E{Gs, Ms, MERGED, 1024}; pg8::gemm_phase<pg8::EpiMerge<1>, pg8::StaticOrder, true, true>(lds, g, S, E, wave); }
        { pg8::Gemm g{HN, WG + (size_t)2 * 1024 * 1024, M, 1024, 1024}; pg8::EpiGate E{Gs, 1024}; pg8::gemm_phase<pg8::EpiGate, pg8::StaticOrder, true, true>(lds, g, S, E, wave); }
        { pg8::Gemm g{(const bf16*)(ob + OUT_MQ), (const bf16*)(ws + WS_WBM), M, 1024, 256}; pg8::EpiMerge<2> E{Gs, Ms, MERGED, 1024}; pg8::gemm_phase<pg8::EpiMerge<2>, pg8::StaticOrder, true, true>(lds, g, S, E, wave); }
    }
    SEAM(PH_MERGE);
    if (IN(PH_OUT)) {
        pg8::StaticOrder S; S.init(M, 1024, G, bx);
        pg8::Gemm g{(const bf16*)(ws + WS_R5), (const bf16*)(ws + WS_WOUT), M, 1024, 1024}; pg8::EpiResid E{args.in[I_X], args.out, 1024};
        pg8::gemm_phase<pg8::EpiResid, pg8::StaticOrder, true, true>(lds, g, S, E, wave);
    }
    SEAM(PH_OUT);
    if (IN(PH_NORM)) { p8_final_norm(args, args.out, vcu, G, wave, lane); }
#undef IN
#undef SEAM
}

extern "C" void kernel_launch(void* const* d_in, const int* in_sizes, int n_in, void* d_out, int out_size, void* d_ws, size_t ws_size, hipStream_t stream) {
    static int grid = 0;
    if (grid == 0) {
        if (n_in != 15 || in_sizes[0] != M * DM || out_size != M * DM || ws_size < WS_END) { fprintf(stderr, "kernel_launch: unexpected shapes (n_in %d, in0 %d, out %d, ws %zu)\n", n_in, n_in > 0 ? in_sizes[0] : -1, out_size, ws_size); grid = -1; return; }
        int dev = 0, cus = 0, per_cu = 0;
        if (hipGetDevice(&dev) != hipSuccess || hipDeviceGetAttribute(&cus, hipDeviceAttributeMultiprocessorCount, dev) != hipSuccess) { grid = -1; return; }
        if (hipFuncSetAttribute((const void*)hyb_fwd, hipFuncAttributeMaxDynamicSharedMemorySize, LDS_BYTES) != hipSuccess) { fprintf(stderr, "kernel_launch: hipFuncSetAttribute failed\n"); grid = -1; return; }
        if (hipOccupancyMaxActiveBlocksPerMultiprocessor(&per_cu, (const void*)hyb_fwd, NTHR, LDS_BYTES) != hipSuccess || per_cu < 1) { fprintf(stderr, "kernel_launch: occupancy query says %d blocks per CU\n", per_cu); (void)hipGetLastError(); grid = -1; return; }
        grid = cus * 1;
    }
    if (grid < 0) return;
    (void)hipMemsetAsync((char*)d_ws + WS_CTL, 0, CTL_ZERO_BYTES, stream);
    Args a{};
    for (int i = 0; i < 15; ++i) a.in[i] = (const float*)d_in[i];
    a.out = (float*)d_out; a.ws = (unsigned char*)d_ws;
#if MK_N_LAUNCHES == 1
    a.ph_lo = 0; a.ph_hi = PH_COUNT;
    void* kargs[] = {&a};
    hipError_t e = hipLaunchCooperativeKernel((const void*)hyb_fwd, dim3(grid), dim3(NTHR), kargs, LDS_BYTES, stream);
    if (e != hipSuccess) fprintf(stderr, "kernel_launch: cooperative launch failed: %s (grid %d)\n", hipGetErrorString(e), grid);
#else
    for (int p = 0; p < PH_COUNT; ++p) {
        a.ph_lo = p; a.ph_hi = p + 1;
        hipLaunchKernelGGL(hyb_fwd, dim3(grid), dim3(NTHR), LDS_BYTES, stream, a);
    }
#endif
}
```

```cpp
#include <hip/hip_runtime.h>
#include <hip/hip_cooperative_groups.h>
#include <cstdio>
#include <cstdint>
namespace cg = cooperative_groups;
namespace pg8 {
#define PG8_LAS __attribute__((address_space(3)))
typedef unsigned short bf16_t;
typedef short bf16x8 __attribute__((ext_vector_type(8)));
typedef float f32x4 __attribute__((ext_vector_type(4)));
typedef unsigned u32x4 __attribute__((ext_vector_type(4)));
constexpr int BM = 256, BK = 64, HALF = 128, HTB = HALF * BK * 2  , STAGE_BYTES = 8 * HTB, NXCD = 8, WGM = 8;

__host__ __device__ __forceinline__ int lds_byte(int r, int c) { const int st = (r >> 4) * 2 + (c >> 5), rr = r & 15, cc = c & 31, ob = rr * 64 + cc * 2; return st * 1024 + (ob ^ (((ob >> 9) & 1) << 5)); }
__host__ __device__ __forceinline__ void stage_rc(int b, int& R, int& C) { const int st = b / 1024, sb = b % 1024, swz = sb ^ (((sb >> 9) & 1) << 5); R = (st >> 1) * 16 + swz / 64; C = (st & 1) * 32 + (swz % 64) / 2; }
__host__ __device__ __forceinline__ int perm32(int rho) { const int n = rho >> 4, i = rho & 15; return 8 * (i >> 2) + 4 * n + (i & 3); }

struct Unit { int pm, pn; };
struct Gemm { const bf16_t* A; const bf16_t* Bt; int M, N, K; };

struct StaticOrder {
    int nM, nN, nwg, G, c;
    __host__ __device__ void init(int M, int N, int G_, int c_) { nM = M / BM; nN = N / BM; nwg = nM * nN; G = G_; c = c_; }
    __host__ __device__ bool next(int i, Unit& u) const {
        const long L = (long)i * G + c; if (L >= nwg) return false;
        int wgid = (int)L; { const int q = nwg / NXCD, r = nwg % NXCD, xcd = wgid % NXCD, off = wgid / NXCD; wgid = (xcd < r ? xcd * (q + 1) : r * (q + 1) + (xcd - r) * q) + off; }
        const int nig = WGM * nN, gid = wgid / nig, fm = gid * WGM, gsz = (nM - fm) < WGM ? (nM - fm) : WGM;
        u.pm = fm + ((wgid % nig) % gsz); u.pn = (wgid % nig) / gsz; return true;
    }
    __device__ __forceinline__ void a_ready(const Unit&) const {}
    __device__ __forceinline__ void done(const Unit&) const {}
};

__device__ __forceinline__ unsigned cvt_pk_bf16(float lo, float hi) { unsigned r; asm volatile("v_cvt_pk_bf16_f32 %0, %1, %2" : "=v"(r) : "v"(lo), "v"(hi)); return r; }
template <class Epi, class Sched, bool ALIGN_EPI = false, bool SP2 = false>
__device__ __forceinline__ void gemm_phase(PG8_LAS unsigned char* lds, const Gemm g, const Sched& S, const Epi& E, const int wid  ) {
    const int lane = (int)__builtin_amdgcn_mbcnt_hi(~0u, __builtin_amdgcn_mbcnt_lo(~0u, 0u)), tid = wid * 64 + lane, wr = wid >> 2, wc = wid & 3, fr = lane & 15, fq = lane >> 4;
    const int K = g.K, nt = K / BK;
    unsigned voffA[2], voffB[2];
#pragma unroll
    for (int i = 0; i < 2; ++i) { int R, C; stage_rc(tid * 16 + i * 8192, R, C); const int Rb = Epi::PERM ? ((R & ~31) + perm32(R & 31)) : R;
        voffA[i] = (unsigned)(R * K + C) * 2u; voffB[i] = (unsigned)(Rb * K + C) * 2u; }
    const size_t kstep = (size_t)(BK * 2);
    const size_t hstep = (size_t)HALF * K * 2;
    const size_t tstep = 2 * hstep;
    const unsigned ldsw = (unsigned)wid * 1024u;
    const int aoff = lds_byte(wr * 64 + fr, fq * 8), boff = lds_byte(wc * 32 + fr, fq * 8);
#define PG8_SA(b, h) (((b) * 2 + (h)) * HTB)
#define PG8_SB(b, h) ((4 + (b) * 2 + (h)) * HTB)
#define PG8_STAGE(bufoff, gbase, voff) do { _Pragma("unroll") for (int _i = 0; _i < 2; ++_i) \
        __builtin_amdgcn_global_load_lds((const unsigned*)((const char*)(gbase) + (voff)[_i]), (PG8_LAS unsigned*)(lds + (bufoff) + ldsw + _i * 8192), 16, 0, 0); } while (0)
#define PG8_LDA(dst, b, h) do { _Pragma("unroll") for (int m = 0; m < 4; ++m) _Pragma("unroll") for (int k = 0; k < 2; ++k) dst[m][k] = *(const PG8_LAS bf16x8*)(lds + PG8_SA(b, h) + aoff + m * 2048 + k * 1024); } while (0)
#define PG8_LDB(dst, b, h) do { _Pragma("unroll") for (int n = 0; n < 2; ++n) _Pragma("unroll") for (int k = 0; k < 2; ++k) dst[n][k] = *(const PG8_LAS bf16x8*)(lds + PG8_SB(b, h) + boff + n * 2048 + k * 1024); } while (0)
#define PG8_MMA(ai, bj, At, Bt) do { __builtin_amdgcn_s_setprio(1); _Pragma("unroll") for (int m = 0; m < 4; ++m) _Pragma("unroll") for (int n = 0; n < 2; ++n) _Pragma("unroll") for (int k = 0; k < 2; ++k) \
        acc[ai][bj][m][n] = __builtin_amdgcn_mfma_f32_16x16x32_bf16(Bt[n][k], At[m][k], acc[ai][bj][m][n], 0, 0, 0); __builtin_amdgcn_s_setprio(0); } while (0)
#define PG8_WAIT_V(n) asm volatile("s_waitcnt vmcnt(" #n ")" ::: "memory")
#define PG8_WAIT_L(n) asm volatile("s_waitcnt lgkmcnt(" #n ")" ::: "memory")
#define PG8_BAR __builtin_amdgcn_s_barrier()
#define PG8_SCHED __builtin_amdgcn_sched_barrier(0)
    Unit cur, nxt; int ui = 0;
    if (!S.next(0, cur)) return;
    f32x4 acc[2][2][4][2];
#pragma unroll
    for (int a = 0; a < 2; ++a)
#pragma unroll
        for (int b = 0; b < 2; ++b)
#pragma unroll
            for (int m = 0; m < 4; ++m)
#pragma unroll
                for (int n = 0; n < 2; ++n) acc[a][b][m][n] = (f32x4){0.f, 0.f, 0.f, 0.f};
    bf16x8 At[4][2], B0[2][2], B1[2][2];
    const char* cA = (const char*)g.A + (size_t)cur.pm * tstep; const char* cB = (const char*)g.Bt + (size_t)cur.pn * tstep;
    S.a_ready(cur);
    if constexpr (SP2) {
        PG8_STAGE(PG8_SB(0, 0), cB, voffB); PG8_STAGE(PG8_SB(0, 1), cB + hstep, voffB); PG8_STAGE(PG8_SA(0, 0), cA, voffA); PG8_STAGE(PG8_SA(0, 1), cA + hstep, voffA);
        if (wr == 1) PG8_BAR;
        PG8_WAIT_V(2); PG8_BAR;
        PG8_STAGE(PG8_SB(1, 0), cB + kstep, voffB); PG8_STAGE(PG8_SA(1, 0), cA + kstep, voffA); PG8_STAGE(PG8_SB(1, 1), cB + hstep + kstep, voffB);
        PG8_WAIT_V(6); PG8_BAR;
    } else {
        PG8_STAGE(PG8_SB(0, 0), cB, voffB); PG8_STAGE(PG8_SA(0, 0), cA, voffA); PG8_STAGE(PG8_SB(0, 1), cB + hstep, voffB); PG8_STAGE(PG8_SA(0, 1), cA + hstep, voffA);
        if (wr == 1) PG8_BAR;
        PG8_WAIT_V(4); PG8_BAR;
        PG8_STAGE(PG8_SB(1, 0), cB + kstep, voffB); PG8_STAGE(PG8_SA(1, 0), cA + kstep, voffA); PG8_STAGE(PG8_SB(1, 1), cB + hstep + kstep, voffB);
        PG8_WAIT_V(6); PG8_BAR;
    }
    for (;;) {
        const bool has_next = S.next(ui + 1, nxt);
        const char* nA = has_next ? (const char*)g.A + (size_t)nxt.pm * tstep : cA; const char* nB = has_next ? (const char*)g.Bt + (size_t)nxt.pn * tstep : cB;
        for (int t = 0; t < nt; t += 2) {
            const bool last = (t == nt - 2);
            const char* a1 = cA + (size_t)(t + 1) * kstep;
            const char* a2 = last ? nA : cA + (size_t)(t + 2) * kstep; const char* b2 = last ? nB : cB + (size_t)(t + 2) * kstep;
            const char* a3 = a2 + kstep; const char* b3 = b2 + kstep;
            if (last && has_next) S.a_ready(nxt);
            if constexpr (SP2) {
            PG8_LDB(B0, 0, 0); PG8_LDB(B1, 0, 1); PG8_SCHED; PG8_LDA(At, 0, 0); PG8_STAGE(PG8_SA(1, 1), a1 + hstep, voffA);
            PG8_WAIT_V(8); PG8_WAIT_L(0); PG8_BAR; PG8_MMA(0, 0, At, B0); PG8_MMA(0, 1, At, B1); PG8_BAR; PG8_SCHED;
            PG8_LDA(At, 0, 1); PG8_STAGE(PG8_SB(0, 0), b2, voffB); PG8_STAGE(PG8_SB(0, 1), b2 + hstep, voffB); PG8_STAGE(PG8_SA(0, 0), a2, voffA);
            PG8_WAIT_V(8); PG8_WAIT_L(0); PG8_BAR; PG8_MMA(1, 0, At, B0); PG8_MMA(1, 1, At, B1); PG8_BAR; PG8_SCHED;
            PG8_LDB(B0, 1, 0); PG8_LDB(B1, 1, 1); PG8_SCHED; PG8_LDA(At, 1, 0); PG8_STAGE(PG8_SA(0, 1), a2 + hstep, voffA);
            PG8_WAIT_V(8); PG8_WAIT_L(0); PG8_BAR; PG8_MMA(0, 0, At, B0); PG8_MMA(0, 1, At, B1); PG8_BAR; PG8_SCHED;
            PG8_LDA(At, 1, 1); PG8_STAGE(PG8_SB(1, 0), b3, voffB); PG8_STAGE(PG8_SB(1, 1), b3 + hstep, voffB); PG8_STAGE(PG8_SA(1, 0), a3, voffA);
            PG8_WAIT_V(8); PG8_WAIT_L(0); PG8_BAR; PG8_MMA(1, 0, At, B0); PG8_MMA(1, 1, At, B1); PG8_BAR; PG8_SCHED;
            } else {
            PG8_LDB(B0, 0, 0); PG8_SCHED; PG8_LDA(At, 0, 0); PG8_STAGE(PG8_SA(1, 1), a1 + hstep, voffA);
            PG8_WAIT_L(8); PG8_BAR; PG8_WAIT_L(0); PG8_MMA(0, 0, At, B0); PG8_BAR; PG8_SCHED;
            PG8_LDB(B1, 0, 1); PG8_STAGE(PG8_SB(0, 0), b2, voffB);
            PG8_BAR; PG8_WAIT_L(0); PG8_MMA(0, 1, At, B1); PG8_BAR;
            PG8_LDA(At, 0, 1); PG8_STAGE(PG8_SA(0, 0), a2, voffA);
            PG8_BAR; PG8_WAIT_L(0); PG8_MMA(1, 0, At, B0); PG8_BAR; PG8_SCHED;
            PG8_STAGE(PG8_SB(0, 1), b2 + hstep, voffB);
            PG8_WAIT_V(6); PG8_BAR; PG8_MMA(1, 1, At, B1); PG8_BAR;
            PG8_LDB(B0, 1, 0); PG8_SCHED; PG8_LDA(At, 1, 0); PG8_STAGE(PG8_SA(0, 1), a2 + hstep, voffA);
            PG8_WAIT_L(8); PG8_BAR; PG8_WAIT_L(0); PG8_MMA(0, 0, At, B0); PG8_BAR; PG8_SCHED;
            PG8_LDB(B1, 1, 1); PG8_STAGE(PG8_SB(1, 0), b3, voffB);
            PG8_BAR; PG8_WAIT_L(0); PG8_MMA(0, 1, At, B1); PG8_BAR;
            PG8_LDA(At, 1, 1); PG8_STAGE(PG8_SA(1, 0), a3, voffA);
            PG8_BAR; PG8_WAIT_L(0); PG8_MMA(1, 0, At, B0); PG8_BAR; PG8_SCHED;
            PG8_STAGE(PG8_SB(1, 1), b3 + hstep, voffB);
            PG8_WAIT_V(6); PG8_BAR; PG8_MMA(1, 1, At, B1); PG8_BAR;
            }
        }
        if constexpr (ALIGN_EPI) { if (wr == 0) PG8_BAR; }
        if constexpr (!Epi::AFTER_DRAIN) { E(acc, cur, wr, wc, fr, fq); S.done(cur); }
        if (!has_next) break;
#pragma unroll
        for (int a = 0; a < 2; ++a)
#pragma unroll
            for (int b = 0; b < 2; ++b)
#pragma unroll
                for (int m = 0; m < 4; ++m)
#pragma unroll
                    for (int n = 0; n < 2; ++n) acc[a][b][m][n] = (f32x4){0.f, 0.f, 0.f, 0.f};
        cur = nxt; cA = nA; cB = nB; ++ui;
        if constexpr (ALIGN_EPI) { if (wr == 1) PG8_BAR; }
    }
    PG8_WAIT_V(0);
    if constexpr (!ALIGN_EPI) { if (wr == 0) PG8_BAR; }
    PG8_BAR;
    if constexpr (Epi::AFTER_DRAIN) { E.fused(acc, cur, wr, wc, fr, fq, lds, wid, lane); S.done(cur); }
#undef PG8_SA
#undef PG8_SB
#undef PG8_STAGE
#undef PG8_LDA
#undef PG8_LDB
#undef PG8_MMA
#undef PG8_WAIT_V
#undef PG8_WAIT_L
#undef PG8_BAR
#undef PG8_SCHED
}
}
namespace pg8 {
__device__ __forceinline__ unsigned short bf_rne(float f) { unsigned u = __builtin_bit_cast(unsigned, f); return (unsigned short)((u + 0x7fffu + ((u >> 16) & 1u)) >> 16); }
__device__ __forceinline__ u32x4 pack8(const f32x4& v0, const f32x4& v1) { u32x4 w; w.x = cvt_pk_bf16(v0[0], v0[1]); w.y = cvt_pk_bf16(v0[2], v0[3]); w.z = cvt_pk_bf16(v1[0], v1[1]); w.w = cvt_pk_bf16(v1[2], v1[3]); return w; }
__device__ __forceinline__ void store_tile_bf16(const f32x4 (&acc)[2][2][4][2], const Unit& u, int wr, int wc, int fr, int fq, bf16_t* base, int ld, int col0, bool tr, int hd, int nh, int srows, bf16_t* halo, int halo_col0) {
    const int row0 = u.pm * BM + wr * 64 + fr, cl0 = wc * 32 + 8 * fq;
#pragma unroll
    for (int ai = 0; ai < 2; ++ai)
#pragma unroll
        for (int m = 0; m < 4; ++m) { const int row = row0 + ai * HALF + m * 16;
#pragma unroll
            for (int bj = 0; bj < 2; ++bj) { const f32x4 v0 = acc[ai][bj][m][0], v1 = acc[ai][bj][m][1]; const int c = col0 + cl0 + bj * HALF;
                { const u32x4 w = pack8(v0, v1); *(u32x4*)(base + (size_t)row * ld + c) = w;
                    if (halo && (row & 63) >= 61) *(u32x4*)(halo + (size_t)((row >> 6) * 3 + (row & 63) - 61) * 3072 + halo_col0 + cl0 + bj * HALF) = w;
                } } }
}
struct EpiG1 {
    static constexpr bool PERM = true, AFTER_DRAIN = false;
    bf16_t *Q, *K, *VT, *Z, *MQ, *MZ;
    __device__ __forceinline__ void operator()(const f32x4 (&acc)[2][2][4][2], const Unit& u, int wr, int wc, int fr, int fq) const {
        const int kind = u.pn >> 2, sub = u.pn & 3;
        if (kind == 4) { store_tile_bf16(acc, u, wr, wc, fr, fq, sub == 0 ? MQ : MZ, 256, 0, false, 0, 0, 0, nullptr, 0); return; }
        bf16_t* base = kind == 0 ? Q : (kind == 1 ? K : (kind == 2 ? VT : Z));
        store_tile_bf16(acc, u, wr, wc, fr, fq, base, 1024, sub * 256, false, 0, 0, 0, nullptr, 0);
    }
};
struct EpiMKV {
    static constexpr bool PERM = true, AFTER_DRAIN = false;
    bf16_t *MKV;
    __device__ __forceinline__ void operator()(const f32x4 (&acc)[2][2][4][2], const Unit& u, int wr, int wc, int fr, int fq) const {
        store_tile_bf16(acc, u, wr, wc, fr, fq, MKV, 512, u.pn * 256, false, 0, 0, 0, nullptr, 0);
    }
};
struct EpiG3 {
    static constexpr bool PERM = true, AFTER_DRAIN = false;
    bf16_t *Q, *K, *V, *Z, *HALO;
    __device__ __forceinline__ void operator()(const f32x4 (&acc)[2][2][4][2], const Unit& u, int wr, int wc, int fr, int fq) const {
        const int kind = u.pn >> 2, sub = u.pn & 3;
        bf16_t* base = kind == 0 ? Q : (kind == 1 ? K : (kind == 2 ? V : Z));
        store_tile_bf16(acc, u, wr, wc, fr, fq, base, 1024, sub * 256, false, 0, 0, 0, kind < 3 ? HALO : nullptr, u.pn * 256);
    }
};
struct EpiGate {
    static constexpr bool PERM = true, AFTER_DRAIN = false;
    bf16_t* Gs; int ldc;
    __device__ __forceinline__ void operator()(const f32x4 (&acc)[2][2][4][2], const Unit& u, int wr, int wc, int fr, int fq) const {
        const int row0 = u.pm * BM + wr * 64 + fr, col0 = u.pn * BM + wc * 32 + 8 * fq;
#pragma unroll
        for (int ai = 0; ai < 2; ++ai)
#pragma unroll
            for (int m = 0; m < 4; ++m)
#pragma unroll
                for (int bj = 0; bj < 2; ++bj) { f32x4 v0 = acc[ai][bj][m][0], v1 = acc[ai][bj][m][1];
#pragma unroll
                    for (int e = 0; e < 4; ++e) { v0[e] = 1.0f / (1.0f + __expf(-v0[e])); v1[e] = 1.0f / (1.0f + __expf(-v1[e])); }
                    *(u32x4*)(Gs + (size_t)(row0 + ai * HALF + m * 16) * ldc + col0 + bj * HALF) = pack8(v0, v1); }
    }
};
template <int MODE> struct EpiMerge {
    static constexpr bool PERM = true, AFTER_DRAIN = false;
    const bf16_t* Gs; float* Ms; bf16_t* Out; int ldc;
    __device__ __forceinline__ void operator()(const f32x4 (&acc)[2][2][4][2], const Unit& u, int wr, int wc, int fr, int fq) const {
        const int row0 = u.pm * BM + wr * 64 + fr, col0 = u.pn * BM + wc * 32 + 8 * fq;
#pragma unroll
        for (int ai = 0; ai < 2; ++ai)
#pragma unroll
            for (int m = 0; m < 4; ++m)
#pragma unroll
                for (int bj = 0; bj < 2; ++bj) { const size_t off = (size_t)(row0 + ai * HALF + m * 16) * ldc + col0 + bj * HALF;
                    const u32x4 g = *(const u32x4*)(Gs + off); f32x4 v0 = acc[ai][bj][m][0], v1 = acc[ai][bj][m][1];
                    f32x4 g0, g1; g0[0] = __builtin_bit_cast(float, g.x << 16); g0[1] = __builtin_bit_cast(float, g.x & 0xffff0000u); g0[2] = __builtin_bit_cast(float, g.y << 16); g0[3] = __builtin_bit_cast(float, g.y & 0xffff0000u);
                    g1[0] = __builtin_bit_cast(float, g.z << 16); g1[1] = __builtin_bit_cast(float, g.z & 0xffff0000u); g1[2] = __builtin_bit_cast(float, g.w << 16); g1[3] = __builtin_bit_cast(float, g.w & 0xffff0000u);
                    v0 = v0 * g0; v1 = v1 * g1;
                    if (MODE == 1 || MODE == 2) { v0 += *(const f32x4*)(Ms + off); v1 += *(const f32x4*)(Ms + off + 4); }
                    if (MODE == 0 || MODE == 1) { *(f32x4*)(Ms + off) = v0; *(f32x4*)(Ms + off + 4) = v1; }
                    else *(u32x4*)(Out + off) = pack8(v0, v1);
                    asm volatile("" ::: "memory"); }
    }
};
struct EpiResid {
    static constexpr bool PERM = false, AFTER_DRAIN = false;
    const float* X; float* Y; int ldc;
    __device__ __forceinline__ void operator()(const f32x4 (&acc)[2][2][4][2], const Unit& u, int wr, int wc, int fr, int fq) const {
        const int row0 = u.pm * BM + wr * 64 + fr, col0 = u.pn * BM + wc * 32 + 4 * fq;
#pragma unroll
        for (int ai = 0; ai < 2; ++ai)
#pragma unroll
            for (int m = 0; m < 4; ++m) { const size_t ro = (size_t)(row0 + ai * HALF + m * 16) * ldc + col0;
#pragma unroll
                for (int bj = 0; bj < 2; ++bj)
#pragma unroll
                    for (int n = 0; n < 2; ++n) { const size_t off = ro + bj * HALF + n * 16; *(f32x4*)(Y + off) = acc[ai][bj][m][n] + *(const f32x4*)(X + off); } }
    }
};
}

#ifndef MK_N_LAUNCHES
#define MK_N_LAUNCHES 1
#endif
constexpr int NWAVES = 8, NTHR = NWAVES * 64;
constexpr int BATCH = 8, SEQ = 2048, DM = 1024, M = BATCH * SEQ;
constexpr int MEM_LEN = 256, MROWS = BATCH * MEM_LEN;
constexpr int IN_WIDTH = 11792;
constexpr int C_DNQKV = 0, C_DNZ = 3072, C_DNB = 4096, C_DNA = 4104, C_SBQKV = 4112, C_SBZ = 7184, C_MQ = 8208, C_MZ = 8464, C_GATE = 8720;
constexpr int N1 = 4608, N3 = 4096, NG = 3072;
constexpr float NORM_EPS = 1e-6f;
constexpr int NHEAD = 8, DH = 128, CH = 64, NCH = SEQ / CH;
constexpr int MH = 4, MDH = 64;

constexpr size_t MiB = 1u << 20;
constexpr size_t WS_CTL = 0, CTL_ZERO_BYTES = 1 * MiB;
constexpr size_t WS_W1T = 1 * MiB, WS_W3T = 10 * MiB, WS_WGT = 18 * MiB, WS_WMKVT = 24 * MiB, WS_WBDN = 25 * MiB, WS_WBSB = 27 * MiB, WS_WBM = 29 * MiB, WS_WOUT = 30 * MiB;
constexpr size_t WS_HN = 32 * MiB;
constexpr size_t WS_R1 = 64 * MiB, WS_R2 = 96 * MiB, WS_R3 = 128 * MiB, WS_R4 = 160 * MiB, WS_R5 = 192 * MiB;
constexpr size_t WS_BG = 224 * MiB, WS_MEMN = 225 * MiB, WS_MK = 229 * MiB  , WS_HALO = 231 * MiB, WS_DECAY = 236 * MiB, WS_END = 237 * MiB;
constexpr size_t OUT_SBQ = 0, OUT_MQ = 32 * MiB, OUT_MZ = 40 * MiB, OUT_A = 48 * MiB;

constexpr int LDS_BYTES = 147456;
#define LAS __attribute__((address_space(3)))
#define GAS __attribute__((address_space(1)))
typedef unsigned short bf16;
typedef float f32x4 __attribute__((ext_vector_type(4)));
typedef float f32x16 __attribute__((ext_vector_type(16)));
typedef short bf16x8 __attribute__((ext_vector_type(8)));
typedef short s16x4 __attribute__((ext_vector_type(4)));
typedef unsigned u32x4 __attribute__((ext_vector_type(4)));
typedef unsigned u32x2 __attribute__((ext_vector_type(2)));

typedef float f32x2_t __attribute__((ext_vector_type(2))); typedef __bf16 bf16x2_t __attribute__((ext_vector_type(2)));
__device__ __forceinline__ unsigned pk2(float lo, float hi) { f32x2_t v = {lo, hi}; bf16x2_t b = __builtin_convertvector(v, bf16x2_t); return __builtin_bit_cast(unsigned, b); }
__device__ __forceinline__ unsigned f2bf(float f) { return (unsigned)__builtin_bit_cast(unsigned short, (__bf16)f); }
__device__ __forceinline__ float bf2f(unsigned short b) { return __builtin_bit_cast(float, (unsigned)b << 16); }
template <int M> __device__ __forceinline__ float shx(float v) { return __builtin_bit_cast(float, __builtin_amdgcn_ds_swizzle(__builtin_bit_cast(int, v), (M << 10) | 0x1f)); }
__device__ __forceinline__ void swap32(float v, float& lo, float& hi) {
    float a_ = v, b_ = v; asm volatile("s_nop 1\n\tv_permlane32_swap_b32 %0, %1" : "+v"(a_), "+v"(b_)); lo = a_; hi = b_; }
__device__ __forceinline__ float sum32(float v) { float lo, hi; swap32(v, lo, hi); return lo + hi; }
__device__ __forceinline__ float max32(float v) { float lo, hi; swap32(v, lo, hi); return fmaxf(lo, hi); }
__device__ __forceinline__ float wave_sum(float v) {
    v += shx<1>(v); v += shx<2>(v); v += shx<4>(v); v += shx<8>(v); v += shx<16>(v);
    return sum32(v);
}
__device__ __forceinline__ int lane_id() {
    int l; asm volatile("v_mbcnt_lo_u32_b32 %0, -1, 0\n\tv_mbcnt_hi_u32_b32 %0, -1, %0" : "=v"(l)); return l; }
__device__ __forceinline__ float sigmoidf_(float x) { return 1.0f / (1.0f + __expf(-x)); }
__device__ __forceinline__ float siluf_(float x) { return x / (1.0f + __expf(-x)); }

struct Args { const float* in[15]; float* out; unsigned char* ws; int ph_lo, ph_hi; };
enum { I_X = 0, I_MEM, I_NORMG, I_MEMNORMG, I_WIN, I_CONVW, I_ALOG, I_DTBIAS, I_DNNORMG, I_WMEMKV, I_WBRDN, I_WBRSB, I_WBRMEM, I_WOUT, I_FINALG };
enum { PH_PRO = 0, PH_GEMM1, PH_ATTN, PH_GEMM3, PH_PREP, PH_SCAN, PH_MERGE, PH_OUT, PH_NORM, PH_COUNT };

__device__ __forceinline__ void p0_transpose_item(const float* W, int ldw, int K, int N, bf16* WT, LAS float* scr, int item, int lane) {
    const int nblk = N / 32, kb = item / nblk, nb = item % nblk, k0 = 64 * kb, n0 = 32 * nb;
#pragma unroll 8
    for (int i = 0; i < 32; ++i) { const int kk = 2 * i + (lane >> 5); scr[kk * 33 + (lane & 31)] = W[(size_t)(k0 + kk) * ldw + n0 + (lane & 31)]; }
    asm volatile("s_waitcnt lgkmcnt(0)" ::: "memory");
    const int c = lane & 7;
#pragma unroll
    for (int j = 0; j < 4; ++j) { const int n = (lane >> 3) + 8 * j; const LAS float* s = scr + (8 * c) * 33 + n;
        u32x4 o; o.x = pk2(s[0 * 33], s[1 * 33]); o.y = pk2(s[2 * 33], s[3 * 33]); o.z = pk2(s[4 * 33], s[5 * 33]); o.w = pk2(s[6 * 33], s[7 * 33]);
        *(u32x4*)(WT + (size_t)(n0 + n) * K + k0 + 8 * c) = o; }
    asm volatile("s_waitcnt lgkmcnt(0)" ::: "memory");
}
__device__ __forceinline__ void rms_row(const float* xrow, const float* g, int lane, f32x4 (&v)[4]) {
    const f32x4* xr = (const f32x4*)xrow + lane; const f32x4* gr = (const f32x4*)g + lane;
    float s = 0.f;
#pragma unroll
    for (int j = 0; j < 4; ++j) { v[j] = xr[64 * j]; s += (v[j].x * v[j].x + v[j].y * v[j].y) + (v[j].z * v[j].z + v[j].w * v[j].w); }
    const float rs = 1.0f / sqrtf(wave_sum(s) * (1.0f / DM) + NORM_EPS);
#pragma unroll
    for (int j = 0; j < 4; ++j) { const f32x4 gg = gr[64 * j]; v[j] = v[j] * rs * gg; }
}
__device__ __forceinline__ void store_row_bf16(bf16* orow, int lane, const f32x4 (&v)[4]) {
    unsigned long long* o8 = (unsigned long long*)orow + lane;
#pragma unroll
    for (int j = 0; j < 4; ++j) o8[64 * j] = (unsigned long long)pk2(v[j].x, v[j].y) | ((unsigned long long)pk2(v[j].z, v[j].w) << 32);
}
__device__ __forceinline__ void p0_prologue(const Args& a, LAS unsigned char* lds, int vcu, int G, int wave, int lane) {
    unsigned char* ws = a.ws;
    const int gw = vcu * NWAVES + wave, NGW = G * NWAVES;
    {
        LAS float* scr = (LAS float*)(lds + wave * 16384);
        const float* win = a.in[I_WIN];
        const int it1 = 16 * (N1 / 32), it3 = 16 * (N3 / 32), itg = 16 * (NG / 32), itkv = 16 * (512 / 32), itb = 16 * (1024 / 32), itm = 4 * (1024 / 32);
        const int total = it1 + it3 + itg + itkv + 3 * itb + itm;
        for (int it = gw; it < total; it += NGW) {
            int r = it;
            if (r < it1) { p0_transpose_item(win + C_SBQKV, IN_WIDTH, 1024, N1, (bf16*)(ws + WS_W1T), scr, r, lane); continue; } r -= it1;
            if (r < it3) { p0_transpose_item(win + C_DNQKV, IN_WIDTH, 1024, N3, (bf16*)(ws + WS_W3T), scr, r, lane); continue; } r -= it3;
            if (r < itg) { p0_transpose_item(win + C_GATE, IN_WIDTH, 1024, NG, (bf16*)(ws + WS_WGT), scr, r, lane); continue; } r -= itg;
            if (r < itkv) { p0_transpose_item(a.in[I_WMEMKV], 512, 1024, 512, (bf16*)(ws + WS_WMKVT), scr, r, lane); continue; } r -= itkv;
            if (r < itb) { p0_transpose_item(a.in[I_WBRDN], 1024, 1024, 1024, (bf16*)(ws + WS_WBDN), scr, r, lane); continue; } r -= itb;
            if (r < itb) { p0_transpose_item(a.in[I_WBRSB], 1024, 1024, 1024, (bf16*)(ws + WS_WBSB), scr, r, lane); continue; } r -= itb;
            if (r < itb) { p0_transpose_item(a.in[I_WOUT], 1024, 1024, 1024, (bf16*)(ws + WS_WOUT), scr, r, lane); continue; } r -= itb;
            p0_transpose_item(a.in[I_WBRMEM], 1024, 256, 1024, (bf16*)(ws + WS_WBM), scr, r, lane);
        }
    }
    __syncthreads();
    {
        LAS float* wbgT = (LAS float*)lds;
        const float* wsrc = a.in[I_WIN] + C_DNB;
        for (int i = wave * 64 + lane; i < 1024 * 16; i += NTHR) { const int k = i >> 4, c = i & 15; wbgT[c * 1028 + k] = wsrc[(size_t)k * IN_WIDTH + c]; }
    }
    __syncthreads();
    {
        LAS float* wbgT = (LAS float*)lds;
        LAS float* hrow = (LAS float*)(lds + 16 * 1028 * 4 + wave * 4096);
        bf16* HN = (bf16*)(ws + WS_HN); float* BG = (float*)(ws + WS_BG);
        const int c = lane & 15, kq = lane >> 4;
        for (int m = gw; m < M; m += NGW) {
            f32x4 v[4]; rms_row(a.in[I_X] + (size_t)m * DM, a.in[I_NORMG], lane, v);
            store_row_bf16(HN + (size_t)m * DM, lane, v);
#pragma unroll
            for (int j = 0; j < 4; ++j) *(LAS f32x4*)(hrow + 256 * j + 4 * lane) = v[j];
            asm volatile("s_waitcnt lgkmcnt(0)" ::: "memory");
            float acc = 0.f;
#pragma unroll 8
            for (int t = 0; t < 64; ++t) { const f32x4 w = *(const LAS f32x4*)(wbgT + c * 1028 + 256 * kq + 4 * t); const f32x4 h = *(const LAS f32x4*)(hrow + 256 * kq + 4 * t);
                acc += (w.x * h.x + w.y * h.y) + (w.z * h.z + w.w * h.w); }
            acc += shx<16>(acc); acc = sum32(acc);
            if (lane < 16) BG[(size_t)m * 16 + lane] = acc;
            asm volatile("s_waitcnt lgkmcnt(0)" ::: "memory");
        }
        bf16* MEMN = (bf16*)(ws + WS_MEMN);
        for (int m = gw; m < MROWS; m += NGW) { f32x4 v[4]; rms_row(a.in[I_MEM] + (size_t)m * DM, a.in[I_MEMNORMG], lane, v); store_row_bf16(MEMN + (size_t)m * DM, lane, v); }
    }
}
__device__ __forceinline__ void p8_final_norm(const Args& a, const float* src, int vcu, int G, int wave, int lane) {
    const int gw = vcu * NWAVES + wave, NGW = G * NWAVES;
    for (int m = gw; m < M; m += NGW) { f32x4 v[4]; rms_row(src + (size_t)m * DM, a.in[I_FINALG], lane, v);
        f32x4* o = (f32x4*)(a.out + (size_t)m * DM) + lane;
#pragma unroll
        for (int j = 0; j < 4; ++j) o[64 * j] = v[j]; }
}
typedef GAS unsigned gu32;
#define RLX_AGENT __ATOMIC_RELAXED, __HIP_MEMORY_SCOPE_AGENT
#define XB_TMO      128
#define XB_XCNT(j)  (256  + 64 * (j))
#define XB_XSUB(j)  (1280 + 64 * (j))
#define XB_XGEN(j)  (2304 + 64 * (j))
#define XB_TOP      3328
#define XB_TOPGEN   3392
#define XCD_BAR_WORDS 3456
#define XB_SPIN_CAP (1u << 18)

__device__ __forceinline__ unsigned xb_ld(unsigned* p)              { return __hip_atomic_load(p, __ATOMIC_RELAXED, __HIP_MEMORY_SCOPE_AGENT); }
__device__ __forceinline__ unsigned xb_add(unsigned* p, unsigned v) { return __hip_atomic_fetch_add(p, v, __ATOMIC_RELAXED, __HIP_MEMORY_SCOPE_AGENT); }
__device__ __forceinline__ unsigned xb_xcc_id() { return (unsigned)__builtin_amdgcn_s_getreg((3 << 11) | 20) & 0xFu; }
#define XB_SPIN(cond, bar) do { unsigned _sp = 0; while (cond) { __builtin_amdgcn_s_sleep(1); \
    if ((++_sp & 255u) == 0u) { if (xb_ld(&(bar)[XB_TMO])) break; if (_sp > XB_SPIN_CAP) { atomicAdd(&(bar)[XB_TMO], 1u); break; } } } } while (0)

struct XcdBarrier {
    unsigned* bar; unsigned x;
    volatile LAS unsigned* st;
};

__device__ __forceinline__ XcdBarrier xcd_barrier_post(unsigned* bar, volatile LAS unsigned* st, bool leader) {
    XcdBarrier b; b.bar = bar; b.x = xb_xcc_id(); b.st = st;
    if (leader) (void)xb_add(&bar[XB_XCNT(b.x)], 1u);
    return b;
}
__device__ __forceinline__ void xcd_barrier_complete(unsigned* bar, unsigned x, unsigned& nloc, unsigned& nx) {
    const unsigned G = gridDim.x * gridDim.y * gridDim.z;
    unsigned sum, cnt, mine, sp = 0u;
    for (;;) {
        sum = 0u; cnt = 0u; mine = 0u;
#pragma unroll
        for (unsigned j = 0; j < 16; ++j) { const unsigned c = xb_ld(&bar[XB_XCNT(j)]); sum += c; cnt += (c > 0u) ? 1u : 0u; mine = (j == x) ? c : mine; }
        if (sum == G) break;
        __builtin_amdgcn_s_sleep(1);
        if ((++sp & 255u) == 0u) { if (xb_ld(&bar[XB_TMO])) break; if (sp > XB_SPIN_CAP) { atomicAdd(&bar[XB_TMO], 1u); break; } }
    }
    nloc = mine > 0u ? mine : 1u; nx = cnt > 0u ? cnt : 1u;
}

__device__ __forceinline__ void xcd_barrier(const XcdBarrier& b, bool leader  ) {
    asm volatile("s_waitcnt vmcnt(0)" ::: "memory");
    __syncthreads();
    if (leader) {
        unsigned* bar = b.bar;
        __builtin_amdgcn_s_waitcnt(0);
        unsigned nloc = b.st[0], nx = b.st[1];
        if (nloc == 0u) { xcd_barrier_complete(bar, b.x, nloc, nx); b.st[0] = nloc; b.st[1] = nx; }
        const unsigned old = xb_add(&bar[XB_XSUB(b.x)], 1u);
        const unsigned gen = old / nloc;
        if (old + 1u == (gen + 1u) * nloc) {
            __builtin_amdgcn_fence(__ATOMIC_RELEASE, "agent");
            asm volatile("s_waitcnt vmcnt(0)" ::: "memory");
            const unsigned og = xb_add(&bar[XB_TOP], 1u);
            const unsigned tg = og / nx;
            if (og + 1u == (tg + 1u) * nx) xb_add(&bar[XB_TOPGEN], 1u);
            else XB_SPIN(xb_ld(&bar[XB_TOPGEN]) == tg, bar);
            __builtin_amdgcn_fence(__ATOMIC_ACQUIRE, "agent");
            xb_add(&bar[XB_XGEN(b.x)], 1u);
            asm volatile("s_waitcnt vmcnt(0)" ::: "memory");
        } else {
            XB_SPIN(xb_ld(&bar[XB_XGEN(b.x)]) == gen, bar);
            __builtin_amdgcn_fence(__ATOMIC_ACQUIRE, "agent");
            asm volatile("s_waitcnt vmcnt(0)" ::: "memory");
        }
    }
    __syncthreads();
}

#define MFMA32(a, b, c) __builtin_amdgcn_mfma_f32_32x32x16_bf16((a), (b), (c), 0, 0, 0)
__device__ __forceinline__ int crow(int r, int h) { return (r & 3) + 8 * (r >> 2) + 4 * h; }
__device__ __forceinline__ bf16x8 ldsfrag(const LAS bf16* p) { return *(const LAS bf16x8*)p; }
__device__ __forceinline__ f32x16 zero16() { f32x16 z;
#pragma unroll
    for (int i = 0; i < 16; ++i) z[i] = 0.f; return z; }
#define LDS_WAIT() asm volatile("s_waitcnt lgkmcnt(0)" ::: "memory")
__device__ __forceinline__ bf16x8 ldsfrag_perm(const LAS bf16* p) {
    const s16x4 lo = *(const LAS s16x4*)p, hi = *(const LAS s16x4*)(p + 8);
    return __builtin_shufflevector(lo, hi, 0, 1, 2, 3, 4, 5, 6, 7);
}


__device__ __forceinline__ void mem_attn_unit(const Args& a, LAS unsigned char* lds, int u, int wave, int lane) {
    const int b = u >> 5, hm = (u >> 3) & 3, tb = u & 7, tid = wave * 64 + lane;
    const bf16* MKV = (const bf16*)(a.ws + WS_MK);
    bf16* MQ = (bf16*)((unsigned char*)a.out + OUT_MQ); const bf16* MZ = (const bf16*)((unsigned char*)a.out + OUT_MZ);
    LAS bf16* MKs = (LAS bf16*)lds;
    LAS bf16* MVTs = (LAS bf16*)(lds + 36864);
    LAS bf16* Pw = (LAS bf16*)(lds + 36864 + 33792 + wave * 4608);
    __syncthreads();
    for (int i = tid; i < 2048; i += NTHR) { const int r = i >> 3, c = i & 7; *(LAS u32x4*)(MKs + r * 72 + c * 8) = *(const u32x4*)(MKV + (size_t)(b * 256 + r) * 512 + hm * 64 + c * 8); }
    for (int i = tid; i < 2048; i += NTHR) { const int m = i & 255, c = i >> 8; const u32x4 v = *(const u32x4*)(MKV + (size_t)(b * 256 + m) * 512 + 256 + hm * 64 + c * 8);
        const unsigned w4[4] = {v.x, v.y, v.z, v.w};
#pragma unroll
        for (int e = 0; e < 8; ++e) MVTs[(c * 8 + e) * 264 + m] = (bf16)(w4[e >> 1] >> ((e & 1) * 16)); }
    __syncthreads();
    const int r32 = lane & 31, hh = lane >> 5;
    const size_t row0 = (size_t)b * SEQ + tb * 256 + wave * 32;
    bf16x8 qf[4];
#pragma unroll
    for (int ks = 0; ks < 4; ++ks) qf[ks] = *(const bf16x8*)(MQ + (row0 + r32) * 256 + hm * 64 + 16 * ks + 8 * hh);
    f32x16 p[8];
#pragma unroll
    for (int mt = 0; mt < 8; ++mt) { p[mt] = zero16();
#pragma unroll
        for (int ks = 0; ks < 4; ++ks) p[mt] = MFMA32(ldsfrag(MKs + (32 * mt + r32) * 72 + 16 * ks + 8 * hh), qf[ks], p[mt]); }
    float mx = -3.0e38f;
#pragma unroll
    for (int mt = 0; mt < 8; ++mt)
#pragma unroll
        for (int r = 0; r < 16; ++r) mx = fmaxf(mx, p[mt][r]);
    mx = max32(mx);
    float sum = 0.f;
#pragma unroll
    for (int mt = 0; mt < 8; ++mt)
#pragma unroll
        for (int r = 0; r < 16; ++r) { const float e = __expf((p[mt][r] - mx) * 0.125f); p[mt][r] = e; sum += e; }
    sum = sum32(sum);
    const float inv = 1.0f / sum;
    f32x16 o[2]; o[0] = zero16(); o[1] = zero16();
#pragma unroll
    for (int c = 0; c < 4; ++c) {
#pragma unroll
        for (int k2 = 0; k2 < 2; ++k2)
#pragma unroll
            for (int g = 0; g < 4; ++g) { const f32x16& pp = p[2 * c + k2]; u32x2 w; w.x = pk2(pp[4 * g] * inv, pp[4 * g + 1] * inv); w.y = pk2(pp[4 * g + 2] * inv, pp[4 * g + 3] * inv);
                *(LAS u32x2*)(Pw + r32 * 72 + 32 * k2 + 8 * g + 4 * hh) = w; }
        LDS_WAIT();
#pragma unroll
        for (int ks = 0; ks < 4; ++ks) { const bf16x8 pa = ldsfrag(Pw + r32 * 72 + 16 * ks + 8 * hh);
#pragma unroll
            for (int dt = 0; dt < 2; ++dt) o[dt] = MFMA32(pa, ldsfrag(MVTs + (32 * dt + r32) * 264 + 64 * c + 16 * ks + 8 * hh), o[dt]); }
        LDS_WAIT();
    }
#pragma unroll
    for (int dt = 0; dt < 2; ++dt)
#pragma unroll
        for (int r = 0; r < 16; ++r) { const size_t off = (row0 + crow(r, hh)) * 256 + hm * 64 + 32 * dt + r32; MQ[off] = (bf16)f2bf(o[dt][r] * siluf_(bf2f(MZ[off]))); }
}

typedef short v4i16_t __attribute__((ext_vector_type(4)));
__device__ __forceinline__ s16x4 lds_tr16(const LAS bf16* p) { return __builtin_bit_cast(s16x4, __builtin_amdgcn_ds_read_tr16_b64_v4i16((LAS v4i16_t*)p)); }
__device__ __forceinline__ bf16x8 pack_acc16(const f32x16& x, int s) {
    u32x4 w; w.x = pk2(x[8 * s], x[8 * s + 1]); w.y = pk2(x[8 * s + 2], x[8 * s + 3]); w.z = pk2(x[8 * s + 4], x[8 * s + 5]); w.w = pk2(x[8 * s + 6], x[8 * s + 7]);
    return __builtin_bit_cast(bf16x8, w);
}
constexpr int SB_KLD = 136, SB_VLD = 160;
constexpr int SB_KB = 64 * SB_KLD * 2, SB_VB = 64 * SB_VLD * 2;
__device__ __forceinline__ void sb_attn_unit(const Args& a, LAS unsigned char* lds, int b, int h, int qb, int wave, int lane) {
    asm volatile("" : "+v"(lane));
    const bf16* K = (const bf16*)(a.ws + WS_R1); const bf16* V = (const bf16*)(a.ws + WS_R2); const bf16* Z = (const bf16*)(a.ws + WS_R3);
    bf16* Q = (bf16*)((unsigned char*)a.out + OUT_SBQ);
    const int r32 = lane & 31, hh = lane >> 5, tid = wave * 64 + lane;
    const int tq0 = 256 * qb + 32 * wave, tq = tq0 + r32;
    const size_t rowb = (size_t)b * SEQ;
    bf16x8 qf[8];
#pragma unroll
    for (int ks = 0; ks < 8; ++ks) qf[ks] = *(const bf16x8*)(Q + (rowb + tq) * 1024 + h * 128 + 16 * ks + 8 * hh);
    f32x16 o[4];
#pragma unroll
    for (int dt = 0; dt < 4; ++dt) o[dt] = zero16();
    float carry = 0.f;
    const float scale2 = 0.08838834764831845f * 1.4426950408889634f;
    const int sr = tid >> 4, sc = tid & 15;
    const bf16* Kg = K + (rowb + sr) * 1024 + h * 128 + sc * 8; const bf16* Vg = V + (rowb + sr) * 1024 + h * 128 + sc * 8;
    u32x4 pk0, pk1, pv0, pv1;
#define SB_LOAD(kt_) do { const size_t o_ = (size_t)(kt_) * 64 * 1024; pk0 = *(const u32x4*)(Kg + o_); pk1 = *(const u32x4*)(Kg + o_ + 32 * 1024); pv0 = *(const u32x4*)(Vg + o_); pv1 = *(const u32x4*)(Vg + o_ + 32 * 1024); } while (0)
#define SB_STORE(buf_) do { LAS bf16* kd_ = (LAS bf16*)(lds + (buf_) * (SB_KB + SB_VB)); LAS bf16* vd_ = (LAS bf16*)(lds + (buf_) * (SB_KB + SB_VB) + SB_KB); \
        *(LAS u32x4*)(kd_ + sr * SB_KLD + sc * 8) = pk0; *(LAS u32x4*)(kd_ + (sr + 32) * SB_KLD + sc * 8) = pk1; *(LAS u32x4*)(vd_ + sr * SB_VLD + sc * 8) = pv0; *(LAS u32x4*)(vd_ + (sr + 32) * SB_VLD + sc * 8) = pv1; } while (0)
    const int kt_hi = 4 * qb + 3;
    __syncthreads();
    SB_LOAD(kt_hi); SB_STORE(0);
    SB_LOAD(kt_hi > 0 ? kt_hi - 1 : 0);
    __syncthreads();
    const int tr_off = ((lane >> 2) & 3) * SB_VLD + 16 * ((lane >> 4) & 1) + 4 * (lane & 3);
    int it = 0;
    for (int kt = kt_hi; kt >= 0; --kt, ++it) {
        const LAS bf16* Ks = (const LAS bf16*)(lds + (it & 1) * (SB_KB + SB_VB)); const LAS bf16* Vs = (const LAS bf16*)(lds + (it & 1) * (SB_KB + SB_VB) + SB_KB);
        if (64 * kt < tq0 + 31) {
            const bool need_mask = (64 * kt + 63 >= tq0);
            float run = carry;
#pragma unroll
            for (int k = 1; k >= 0; --k) {
                f32x16 p = zero16();
#pragma unroll
                for (int ks = 0; ks < 8; ++ks) p = MFMA32(ldsfrag(Ks + (32 * k + r32) * SB_KLD + 16 * ks + 8 * hh), qf[ks], p);
                f32x16 lf; float gs[4];
#pragma unroll
                for (int g = 0; g < 4; ++g) { float s4 = 0.f;
#pragma unroll
                    for (int j = 0; j < 4; ++j) { const int r = 4 * g + j; const float z = p[r] * scale2; const float l1p = __builtin_amdgcn_logf(1.0f + __builtin_amdgcn_exp2f(-fabsf(z)));
                        float lbv = fminf(z, 0.f) - l1p, lfv = fminf(-z, 0.f) - l1p;
                        if (need_mask) { const bool causal = (64 * kt + 32 * k + crow(r, hh)) < tq; lbv = causal ? lbv : -1.0e30f; lfv = causal ? lfv : 0.f; }
                        p[r] = lbv; lf[r] = lfv; s4 += lfv; }
                    gs[g] = s4; }
#pragma unroll
                for (int g = 3; g >= 0; --g) { float g_lo, g_hi; swap32(gs[g], g_lo, g_hi);
                    float sv = hh ? run : run + g_hi;
                    run += g_hi + g_lo;
#pragma unroll
                    for (int j = 3; j >= 0; --j) { const int r = 4 * g + j; const float att = __builtin_amdgcn_exp2f(p[r] + sv); sv += lf[r]; p[r] = att; } }
#pragma unroll
                for (int s2 = 0; s2 < 2; ++s2) { const bf16x8 pb = pack_acc16(p, s2); const LAS bf16* vb = Vs + (32 * k + 16 * s2 + 4 * hh) * SB_VLD + tr_off;
#pragma unroll
                    for (int dt = 0; dt < 4; ++dt) { const s16x4 lo = lds_tr16(vb + 32 * dt), hi = lds_tr16(vb + 8 * SB_VLD + 32 * dt);
                        o[dt] = MFMA32(__builtin_shufflevector(lo, hi, 0, 1, 2, 3, 4, 5, 6, 7), pb, o[dt]); } }
            }
            carry = run;
        }
        SB_STORE((it + 1) & 1);
        SB_LOAD(kt >= 2 ? kt - 2 : 0);
        if (__syncthreads_and(carry < -160.0f)) break;
    }
#undef SB_LOAD
#undef SB_STORE
#pragma unroll
    for (int dt = 0; dt < 4; ++dt)
#pragma unroll
        for (int g = 0; g < 4; ++g) { const size_t off = (rowb + tq) * 1024 + h * 128 + 32 * dt + 8 * g + 4 * hh;
            const u32x2 zz = *(const u32x2*)(Z + off); float y[4];
            const float z0 = __builtin_bit_cast(float, zz.x << 16), z1 = __builtin_bit_cast(float, zz.x & 0xffff0000u), z2 = __builtin_bit_cast(float, zz.y << 16), z3 = __builtin_bit_cast(float, zz.y & 0xffff0000u);
            y[0] = o[dt][4 * g] * z0 * __builtin_amdgcn_rcpf(1.0f + __expf(-z0)); y[1] = o[dt][4 * g + 1] * z1 * __builtin_amdgcn_rcpf(1.0f + __expf(-z1));
            y[2] = o[dt][4 * g + 2] * z2 * __builtin_amdgcn_rcpf(1.0f + __expf(-z2)); y[3] = o[dt][4 * g + 3] * z3 * __builtin_amdgcn_rcpf(1.0f + __expf(-z3));
            u32x2 w; w.x = pk2(y[0], y[1]); w.y = pk2(y[2], y[3]); *(u32x2*)(Q + off) = w; }
}
__device__ __forceinline__ void p2_attention(const Args& a, LAS unsigned char* lds, int vcu, int G, int wave, int lane) {
    for (int u = vcu; u < 256; u += G) mem_attn_unit(a, lds, u, wave, lane);
    for (int u = vcu; u < 512; u += G) { const int v = u & 255, bh = v >> 2, j = v & 3; sb_attn_unit(a, lds, bh >> 3, bh & 7, u < 256 ? j : 7 - j, wave, lane); }
    __syncthreads();
}
__device__ __forceinline__ void nfma(float& acc, float a, float b) { asm("v_fma_f32 %0, -%1, %2, %0" : "+v"(acc) : "v"(a), "v"(b)); }
template <int I, int OFF> struct SolveRows32 {
    static __device__ __forceinline__ void run(float (&Tc)[32], const LAS float* MT, int j) {
        float acc[4] = {(I == j) ? 1.f : 0.f, 0.f, 0.f, 0.f};
#pragma unroll
        for (int k4 = 0; k4 < (I + 3) / 4; ++k4) { const f32x4 m = *(const LAS f32x4*)(MT + (OFF + I) * 68 + OFF + 4 * k4);
            nfma(acc[0], m.x, Tc[4 * k4]);
            if (4 * k4 + 1 < I) nfma(acc[1], m.y, Tc[4 * k4 + 1]);
            if (4 * k4 + 2 < I) nfma(acc[2], m.z, Tc[4 * k4 + 2]);
            if (4 * k4 + 3 < I) nfma(acc[3], m.w, Tc[4 * k4 + 3]); }
        Tc[I] = (acc[0] + acc[1]) + (acc[2] + acc[3]);
        if ((I & 3) == 3) asm volatile("" ::: "memory");
        SolveRows32<I + 1, OFF>::run(Tc, MT, j);
    }
};
template <int OFF> struct SolveRows32<32, OFF> { static __device__ __forceinline__ void run(float (&)[32], const LAS float*, int) {} };
__device__ __forceinline__ void dn_prep_item(const Args& a, LAS unsigned char* lds, int item, int wave, int lane) {
    asm volatile("" : "+v"(lane));
    const int b = item >> 8, h = (item >> 5) & 7, n = item & 31; int tid = wave * 64 + lane;
    const size_t rowb = (size_t)b * SEQ + n * CH;
    bf16* R1 = (bf16*)(a.ws + WS_R1); bf16* R2 = (bf16*)(a.ws + WS_R2); bf16* R3 = (bf16*)(a.ws + WS_R3); bf16* R5 = (bf16*)(a.ws + WS_R5);
    const bf16* HALO = (const bf16*)(a.ws + WS_HALO); const float* BG = (const float*)(a.ws + WS_BG);
    bf16* AO = (bf16*)((unsigned char*)a.out + OUT_A) + (size_t)item * 4096;
    LAS bf16* QS = (LAS bf16*)lds;
    LAS bf16* KS = (LAS bf16*)(lds + 17408);
    LAS bf16* KBT = (LAS bf16*)(lds + 34816);
    LAS bf16* VBT = (LAS bf16*)(lds + 53248);
    LAS float* MT = (LAS float*)(lds + 71680);
    LAS bf16* TB = (LAS bf16*)(lds + 89088);
    LAS float* GL = (LAS float*)(lds + 98304);
    LAS float* BL = GL + 64;
    LAS float* CW = (LAS float*)(lds + 98816);
    LAS bf16* AIT = (LAS bf16*)(lds + 104960);
    LAS bf16* CB = (LAS bf16*)(lds + 110080);
#ifdef PROBE_PREP
    unsigned long long pp_tl = __builtin_amdgcn_s_memrealtime();
#define PP_MARK(k) do { const unsigned long long now_ = __builtin_amdgcn_s_memrealtime(); if (PROBE_PREP == (k) && blockIdx.x == 0 && wave == 0 && lane_id() == 0) ((volatile LAS unsigned long long*)(lds + LDS_BYTES - 128))[1] += now_ - pp_tl; pp_tl = now_; } while (0)
#else
#define PP_MARK(k) do { } while (0)
#endif
    __syncthreads();
    PP_MARK(10);
    if (wave == 0) {
        const float bb = BG[(rowb + lane) * 16 + h], aa = BG[(rowb + lane) * 16 + 8 + h];
        const float x = aa + a.in[I_DTBIAS][h];
        const float sp = fmaxf(x, 0.f) + log1pf(expf(-fabsf(x)));
        float g = -expf(a.in[I_ALOG][h]) * sp;
#pragma unroll
        for (int o = 1; o < 64; o <<= 1) { const float t = __builtin_bit_cast(float, __builtin_amdgcn_ds_bpermute((lane - o) << 2, __builtin_bit_cast(int, g))); if (lane >= o) g += t; }
        GL[lane] = g; BL[lane] = 1.0f / (1.0f + expf(-bb));
    }
    for (int i = tid; i < 4 * 384; i += NTHR) { const int j = i / 384, rem = i % 384, ten = rem >> 7, c = rem & 127; CW[i] = a.in[I_CONVW][j * 3072 + ten * 1024 + h * 128 + c]; }

    {
        const int cc = tid & 15, rg = tid >> 4, r0 = 2 * rg;
        const int gcol = h * 128 + cc * 8;
        u32x4 raw[3][5];
#pragma unroll
        for (int ten = 0; ten < 3; ++ten) { const bf16* src = ten == 0 ? R1 : (ten == 1 ? R2 : R3);
#pragma unroll
            for (int j = 0; j < 5; ++j) { const int r = r0 - 3 + j;
                if (r >= 0) raw[ten][j] = *(const u32x4*)(src + (rowb + r) * 1024 + gcol);
                else if (n > 0) raw[ten][j] = *(const u32x4*)(HALO + (size_t)((b * NCH + n - 1) * 3 + (r + 3)) * 3072 + ten * 1024 + gcol);
                else raw[ten][j] = (u32x4){0u, 0u, 0u, 0u}; } }
        __syncthreads();
        PP_MARK(11);
#pragma unroll
        for (int ten = 0; ten < 3; ++ten) {
            float wq[4][8];
#pragma unroll
            for (int j = 0; j < 4; ++j) { const f32x4 w0 = *(const LAS f32x4*)(CW + j * 384 + ten * 128 + cc * 8), w1 = *(const LAS f32x4*)(CW + j * 384 + ten * 128 + cc * 8 + 4);
                wq[j][0] = w0.x; wq[j][1] = w0.y; wq[j][2] = w0.z; wq[j][3] = w0.w; wq[j][4] = w1.x; wq[j][5] = w1.y; wq[j][6] = w1.z; wq[j][7] = w1.w; }
#pragma unroll
            for (int rr = 0; rr < 2; ++rr) { const int r = r0 + rr; float y[8]; float ss = 0.f;
#pragma unroll
                for (int e = 0; e < 8; ++e) { float sacc = 0.f;
#pragma unroll
                    for (int j = 0; j < 4; ++j) { const u32x4 v = raw[ten][rr + j]; const unsigned w = (e >> 1) == 0 ? v.x : ((e >> 1) == 1 ? v.y : ((e >> 1) == 2 ? v.z : v.w));
                        sacc += wq[j][e] * __builtin_bit_cast(float, (e & 1) ? (w & 0xffff0000u) : (w << 16)); }
                    y[e] = sacc * __builtin_amdgcn_rcpf(1.0f + __expf(-sacc)); ss += y[e] * y[e]; }
                if (ten < 2) { ss += shx<1>(ss); ss += shx<2>(ss); ss += shx<4>(ss); ss += shx<8>(ss);
                    const float sc = __builtin_amdgcn_rsqf(ss + NORM_EPS) * (ten == 0 ? 0.08838834764831845f : 1.0f);
#pragma unroll
                    for (int e = 0; e < 8; ++e) y[e] *= sc;
                    u32x4 w; w.x = pk2(y[0], y[1]); w.y = pk2(y[2], y[3]); w.z = pk2(y[4], y[5]); w.w = pk2(y[6], y[7]);
                    *(LAS u32x4*)((ten == 0 ? QS : KS) + r * 136 + cc * 8) = w;
                    if (ten == 1) { const float f = BL[r] * __expf(GL[r]);
#pragma unroll
                        for (int e = 0; e < 8; ++e) KBT[(cc * 8 + e) * 72 + r] = (bf16)f2bf(y[e] * f); }
                } else { const float f = BL[r];
#pragma unroll
                    for (int e = 0; e < 8; ++e) VBT[(cc * 8 + e) * 72 + r] = (bf16)f2bf(y[e] * f); } }
            asm volatile("" ::: "memory");
        }
    }
    __syncthreads();
    PP_MARK(12);
    int r32 = lane & 31, hh = lane >> 5;
    {
        const int which = wave >> 2, ti = (wave >> 1) & 1, tj = wave & 1;
        const LAS bf16* X = which ? QS : KS;
        f32x16 c = zero16();
#pragma unroll
        for (int ks = 0; ks < 8; ++ks) c = MFMA32(ldsfrag(X + (32 * ti + r32) * 136 + 16 * ks + 8 * hh), ldsfrag(KS + (32 * tj + r32) * 136 + 16 * ks + 8 * hh), c);
        const int j = 32 * tj + r32; const float Gj = GL[j];
#pragma unroll
        for (int r = 0; r < 16; ++r) { const int i = 32 * ti + crow(r, hh); const float Gi = GL[i];
            if (which == 0) { const float mv = (i > j) ? BL[i] * c[r] * __expf(Gi - Gj) : 0.f; MT[i * 68 + j] = mv; if (ti == 1 && tj == 0) CB[(i - 32) * 40 + j] = (bf16)f2bf(mv); }
            else AO[i * 64 + j] = (bf16)f2bf((i >= j) ? c[r] * __expf(Gi - Gj) : 0.f); }
    }
    __syncthreads();
    PP_MARK(13);
    if (wave < 2) {
        const int j = lane & 31;
        float Tc[32];
        const LAS float* MTv = MT; asm volatile("" : "+v"(MTv));
        if (wave == 0) SolveRows32<0, 0>::run(Tc, MTv, j); else SolveRows32<0, 32>::run(Tc, MTv, j);
        if (lane < 32) {
            const int off = wave * 32;
#pragma unroll
            for (int i = 0; i < 32; ++i) TB[(off + i) * 72 + off + j] = (bf16)f2bf(Tc[i]);
            if (wave == 0) {
#pragma unroll
                for (int i = 0; i < 32; ++i) TB[i * 72 + 32 + j] = (bf16)0;
#pragma unroll
                for (int q = 0; q < 4; ++q) { u32x4 w; w.x = pk2(Tc[8 * q], Tc[8 * q + 1]); w.y = pk2(Tc[8 * q + 2], Tc[8 * q + 3]); w.z = pk2(Tc[8 * q + 4], Tc[8 * q + 5]); w.w = pk2(Tc[8 * q + 6], Tc[8 * q + 7]);
                    *(LAS u32x4*)(AIT + j * 40 + 8 * q) = w; }
            }
        }
    }
    __syncthreads();
    if (wave == 0) {
        const int r32 = lane & 31, hh = lane >> 5;
        f32x16 x = zero16();
#pragma unroll
        for (int s2 = 0; s2 < 2; ++s2) x = MFMA32(ldsfrag(CB + r32 * 40 + 16 * s2 + 8 * hh), ldsfrag(AIT + r32 * 40 + 16 * s2 + 8 * hh), x);
        f32x16 t = zero16();
#pragma unroll
        for (int s2 = 0; s2 < 2; ++s2) t = MFMA32(pack_acc16(x, s2), ldsfrag_perm(TB + (32 + r32) * 72 + 32 + 16 * s2 + 4 * hh), t);
#pragma unroll
        for (int g = 0; g < 4; ++g) { u32x2 w; w.x = pk2(-t[4 * g], -t[4 * g + 1]); w.y = pk2(-t[4 * g + 2], -t[4 * g + 3]); *(LAS u32x2*)(TB + (32 + r32) * 72 + 8 * g + 4 * hh) = w; }
    }
    __syncthreads();
    PP_MARK(14);
    asm volatile("" : "+v"(lane)); r32 = lane & 31; hh = lane >> 5; tid = wave * 64 + lane;
    {
        { const int ci = wave >> 2, ej = wave & 3; f32x16 c = zero16();
#pragma unroll
          for (int ks = 0; ks < 4; ++ks) c = MFMA32(ldsfrag(TB + (32 * ci + r32) * 72 + 16 * ks + 8 * hh), ldsfrag(VBT + (32 * ej + r32) * 72 + 16 * ks + 8 * hh), c);
          {
              u32x4 w0, w1; w0.x = pk2(c[0], c[1]); w0.y = pk2(c[2], c[3]); w0.z = pk2(c[4], c[5]); w0.w = pk2(c[6], c[7]); w1.x = pk2(c[8], c[9]); w1.y = pk2(c[10], c[11]); w1.z = pk2(c[12], c[13]); w1.w = pk2(c[14], c[15]);
              bf16* dst = R3 + (rowb + 8 * (4 * ci + ej) + (lane >> 3)) * 1024 + h * 128 + (lane & 7) * 16;
              *(u32x4*)dst = w0; *(u32x4*)(dst + 8) = w1; } }
        { const int ci = wave >> 2, dj = wave & 3; f32x16 c = zero16();
#pragma unroll
          for (int ks = 0; ks < 4; ++ks) c = MFMA32(ldsfrag(TB + (32 * ci + r32) * 72 + 16 * ks + 8 * hh), ldsfrag(KBT + (32 * dj + r32) * 72 + 16 * ks + 8 * hh), c);
#pragma unroll
          for (int r = 0; r < 16; ++r) { const int cidx = 32 * ci + crow(r, hh), d = 32 * dj + r32; R2[(rowb + cidx) * 1024 + h * 128 + d] = (bf16)f2bf(c[r]); } }
    }
    PP_MARK(15);
    {
        const float Glast = GL[63];
        for (int i = tid; i < 1024; i += NTHR) { const int r = i >> 4, c8 = i & 15; const float f = __expf(GL[r]);
            const u32x4 v = *(const LAS u32x4*)(QS + r * 136 + c8 * 8); const unsigned w4[4] = {v.x, v.y, v.z, v.w}; float y[8];
#pragma unroll
            for (int e = 0; e < 8; ++e) y[e] = __builtin_bit_cast(float, (w4[e >> 1] >> ((e & 1) * 16)) << 16) * f;
            u32x4 w; w.x = pk2(y[0], y[1]); w.y = pk2(y[2], y[3]); w.z = pk2(y[4], y[5]); w.w = pk2(y[6], y[7]);
            *(u32x4*)(R1 + (rowb + r) * 1024 + h * 128 + c8 * 8) = w; }
        for (int i = tid; i < 1024; i += NTHR) { const int d = i & 127, c8 = i >> 7; float y[8];
#pragma unroll
            for (int e = 0; e < 8; ++e) { const int c = c8 * 8 + e; y[e] = bf2f(KS[c * 136 + d]) * __expf(Glast - GL[c]); }
            u32x4 w; w.x = pk2(y[0], y[1]); w.y = pk2(y[2], y[3]); w.z = pk2(y[4], y[5]); w.w = pk2(y[6], y[7]);
            *(u32x4*)(R5 + (rowb + (d >> 1)) * 1024 + h * 128 + (d & 1) * 64 + c8 * 8) = w; }
        if (tid == 0) ((float*)(a.ws + WS_DECAY))[item] = __expf(Glast);
    }
    PP_MARK(16);
#undef PP_MARK
}

__device__ __forceinline__ bf16x8 pack_acc(const f32x16& x, int s) {
    u32x4 w; w.x = pk2(x[8 * s], x[8 * s + 1]); w.y = pk2(x[8 * s + 2], x[8 * s + 3]); w.z = pk2(x[8 * s + 4], x[8 * s + 5]); w.w = pk2(x[8 * s + 6], x[8 * s + 7]);
    return __builtin_bit_cast(bf16x8, w);
}
#define WG_BARRIER() do { asm volatile("s_waitcnt lgkmcnt(0)" ::: "memory"); __builtin_amdgcn_s_barrier(); asm volatile("" ::: "memory"); } while (0)
template <int SHADOW>
__device__ __forceinline__ void dn_scan_unit(const Args& a, LAS unsigned char* lds, int bh, int wave, int lane) {
    asm volatile("" : "+v"(lane));
#ifdef PROBE_REGION
    unsigned long long pr_acc = 0ull, pr_tl = 0ull;
#define PR_MARK(k) do { const unsigned long long now_ = __builtin_amdgcn_s_memrealtime(); if (PROBE_REGION == (k)) pr_acc += now_ - pr_tl; pr_tl = now_; } while (0)
#else
#define PR_MARK(k) do { } while (0)
#endif
    const int b = bh >> 3, h = bh & 7;
    const bf16* R1 = (const bf16*)(a.ws + WS_R1); const bf16* R2 = (const bf16*)(a.ws + WS_R2); const bf16* R3 = (const bf16*)(a.ws + WS_R3); const bf16* R5 = (const bf16*)(a.ws + WS_R5);
    bf16* R4 = (bf16*)(a.ws + WS_R4);
    const float* DEC = (const float*)(a.ws + WS_DECAY);
    constexpr int OPB = 17408 + 17408 + 18432 + 9216, O_QD = 17408, O_KDT = 34816, O_A = 53248;
    LAS bf16* OB = (LAS bf16*)(lds + 2 * OPB);
    LAS float* GN = (LAS float*)(lds + 2 * OPB + 17408);
    const size_t colh = (size_t)h * 128; const size_t rowb0 = (size_t)b * SEQ; const int item0 = (b * 8 + h) * NCH;
    const bf16* AOg = (const bf16*)((const unsigned char*)a.out + OUT_A) + (size_t)item0 * 4096;
    __syncthreads();
    if (wave * 64 + lane < 128) GN[wave * 64 + lane] = a.in[I_DNNORMG][wave * 64 + lane];
    if (wave < 4) {
        const int sl = wave, e0 = 32 * sl; int r32 = lane & 31, hh = lane >> 5;
        f32x16 S[4];
#pragma unroll
        for (int dt = 0; dt < 4; ++dt) S[dt] = zero16();
        u32x4 pu[2][2]; float pdec;
#define SCAN_LOAD_U(n_) do { _Pragma("unroll") for (int ci_ = 0; ci_ < 2; ++ci_) { const bf16* src_ = R3 + (rowb0 + (size_t)(SHADOW == 2 ? 0 : (n_)) * CH + 8 * (4 * ci_ + sl) + (lane >> 3)) * 1024 + colh + (lane & 7) * 16; pu[ci_][0] = *(const u32x4*)src_; pu[ci_][1] = *(const u32x4*)(src_ + 8); } } while (0)
        SCAN_LOAD_U(0); pdec = DEC[item0];
        WG_BARRIER();
        for (int n = 0; n < NCH; ++n) {
            asm volatile("" : "+v"(lane)); r32 = lane & 31; hh = lane >> 5;
            PR_MARK(0);
            LAS unsigned char* ob = lds + (n & 1) * OPB;
            const LAS bf16* Wl = (const LAS bf16*)ob; const LAS bf16* QDl = (const LAS bf16*)(ob + O_QD); const LAS bf16* KDTl = (const LAS bf16*)(ob + O_KDT); const LAS bf16* Al = (const LAS bf16*)(ob + O_A);
            const int nn = n + 1 < NCH ? n + 1 : n;
            bf16x8 Sp[4][2];
#pragma unroll
            for (int dt = 0; dt < 4; ++dt) { Sp[dt][0] = pack_acc(S[dt], 0); Sp[dt][1] = pack_acc(S[dt], 1); }
            f32x16 vn[2];
#pragma unroll
            for (int ci = 0; ci < 2; ++ci) { f32x16 c = zero16();
#pragma unroll
                for (int dt = 0; dt < 4; ++dt)
#pragma unroll
                    for (int s2 = 0; s2 < 2; ++s2) c = MFMA32(ldsfrag(Wl + (32 * ci + r32) * 136 + 32 * dt + 16 * s2 + 8 * hh), Sp[dt][s2], c);
                const unsigned uw[8] = {pu[ci][0].x, pu[ci][0].y, pu[ci][0].z, pu[ci][0].w, pu[ci][1].x, pu[ci][1].y, pu[ci][1].z, pu[ci][1].w};
#pragma unroll
                for (int r = 0; r < 16; ++r) vn[ci][r] = __builtin_bit_cast(float, (uw[r >> 1] >> ((r & 1) * 16)) << 16) - c[r]; }
            SCAN_LOAD_U(nn);
            bf16x8 Vp[2][2];
#pragma unroll
            for (int cs = 0; cs < 2; ++cs) { Vp[cs][0] = pack_acc(vn[cs], 0); Vp[cs][1] = pack_acc(vn[cs], 1); }
            f32x16 o[2];
#pragma unroll
            for (int ci = 0; ci < 2; ++ci) { f32x16 c = zero16();
#pragma unroll
                for (int dt = 0; dt < 4; ++dt)
#pragma unroll
                    for (int s2 = 0; s2 < 2; ++s2) c = MFMA32(ldsfrag(QDl + (32 * ci + r32) * 136 + 32 * dt + 16 * s2 + 8 * hh), Sp[dt][s2], c);
#pragma unroll
                for (int cs = 0; cs < 2; ++cs)
#pragma unroll
                    for (int s2 = 0; s2 < 2; ++s2) c = MFMA32(ldsfrag(Al + (32 * ci + r32) * 72 + 32 * cs + 16 * s2 + 8 * hh), Vp[cs][s2], c);
                o[ci] = c; }
#pragma unroll
            for (int dt = 0; dt < 4; ++dt) { f32x16 c = S[dt] * pdec;
#pragma unroll
                for (int cs = 0; cs < 2; ++cs)
#pragma unroll
                    for (int s2 = 0; s2 < 2; ++s2) c = MFMA32(ldsfrag(KDTl + (32 * dt + r32) * 72 + 32 * cs + 16 * s2 + 8 * hh), Vp[cs][s2], c);
                S[dt] = c; }
            pdec = DEC[item0 + nn];
            PR_MARK(1);
            WG_BARRIER();
            PR_MARK(2);
#pragma unroll
            for (int ci = 0; ci < 2; ++ci)
#pragma unroll
                for (int r = 0; r < 16; ++r) OB[(32 * ci + crow(r, hh)) * 136 + e0 + r32] = (bf16)f2bf(o[ci][r]);
            PR_MARK(3);
            WG_BARRIER();
            PR_MARK(4);
        }
#undef SCAN_LOAD_U
        WG_BARRIER();
    } else {
        int hid = (wave - 4) * 64 + lane;
        u32x4 pw[4], pq[4], pk[4], pa[2], pz[4];
#define SCAN_LOAD_OPS(n_) do { const size_t rb_ = rowb0 + (size_t)(SHADOW == 2 ? 0 : (n_)) * CH; \
            _Pragma("unroll") for (int j_ = 0; j_ < 2; ++j_) { const int i_ = hid + j_ * 256; const int r_ = i_ >> 3, g_ = i_ & 7; \
                const bf16* sw_ = R2 + (rb_ + r_) * 1024 + colh + g_ * 16; pw[2 * j_] = *(const u32x4*)sw_; pw[2 * j_ + 1] = *(const u32x4*)(sw_ + 8); \
                const bf16* sq_ = R1 + (rb_ + r_) * 1024 + colh + g_ * 16; pq[2 * j_] = *(const u32x4*)sq_; pq[2 * j_ + 1] = *(const u32x4*)(sq_ + 8); \
                const int e_ = i_ >> 2, k_ = i_ & 3; const bf16* sk_ = R5 + (rb_ + (e_ >> 1)) * 1024 + colh + (e_ & 1) * 64 + k_ * 16; pk[2 * j_] = *(const u32x4*)sk_; pk[2 * j_ + 1] = *(const u32x4*)(sk_ + 8); } \
            { const bf16* sa_ = AOg + (size_t)(SHADOW == 2 ? 0 : (n_)) * 4096 + hid * 16; pa[0] = *(const u32x4*)sa_; pa[1] = *(const u32x4*)(sa_ + 8); } } while (0)
#define SWZ_LO(x_, y_) ((u32x4){(x_).x, (x_).y, (y_).x, (y_).y})
#define SWZ_HI(x_, y_) ((u32x4){(x_).z, (x_).w, (y_).z, (y_).w})
#define SCAN_STORE_OPS(buf_) do { LAS unsigned char* ob_ = lds + (buf_) * OPB; \
            _Pragma("unroll") for (int j_ = 0; j_ < 2; ++j_) { const int i_ = hid + j_ * 256; const int r_ = i_ >> 3, g_ = i_ & 7; \
                LAS bf16* dw_ = (LAS bf16*)ob_ + r_ * 136 + g_ * 16; *(LAS u32x4*)dw_ = SWZ_LO(pw[2 * j_], pw[2 * j_ + 1]); *(LAS u32x4*)(dw_ + 8) = SWZ_HI(pw[2 * j_], pw[2 * j_ + 1]); \
                LAS bf16* dq_ = (LAS bf16*)(ob_ + O_QD) + r_ * 136 + g_ * 16; *(LAS u32x4*)dq_ = SWZ_LO(pq[2 * j_], pq[2 * j_ + 1]); *(LAS u32x4*)(dq_ + 8) = SWZ_HI(pq[2 * j_], pq[2 * j_ + 1]); \
                const int e_ = i_ >> 2, k_ = i_ & 3; LAS bf16* dk_ = (LAS bf16*)(ob_ + O_KDT) + e_ * 72 + k_ * 16; *(LAS u32x4*)dk_ = SWZ_LO(pk[2 * j_], pk[2 * j_ + 1]); *(LAS u32x4*)(dk_ + 8) = SWZ_HI(pk[2 * j_], pk[2 * j_ + 1]); } \
            { LAS bf16* da_ = (LAS bf16*)(ob_ + O_A) + (hid >> 2) * 72 + (hid & 3) * 16; *(LAS u32x4*)da_ = SWZ_LO(pa[0], pa[1]); *(LAS u32x4*)(da_ + 8) = SWZ_HI(pa[0], pa[1]); } } while (0)
#define SCAN_LOAD_Z(n_) do { const size_t rb_ = rowb0 + (size_t)(SHADOW == 2 ? 0 : (n_)) * CH; const bf16* src_ = R4 + (rb_ + (hid >> 2)) * 1024 + colh + (hid & 3) * 32; \
            _Pragma("unroll") for (int j_ = 0; j_ < 4; ++j_) pz[j_] = *(const u32x4*)(src_ + 8 * j_); } while (0)
#define SCAN_EPILOGUE(n_) do { const int c_ = hid >> 2, q4_ = hid & 3; float ov_[32]; float ss_ = 0.f; \
            _Pragma("unroll") for (int j_ = 0; j_ < 4; ++j_) { const u32x4 t_ = *(const LAS u32x4*)(OB + c_ * 136 + 32 * q4_ + 8 * j_); const unsigned tw_[4] = {t_.x, t_.y, t_.z, t_.w}; \
                _Pragma("unroll") for (int e_ = 0; e_ < 8; ++e_) { const float v_ = __builtin_bit_cast(float, (tw_[e_ >> 1] >> ((e_ & 1) * 16)) << 16); ov_[8 * j_ + e_] = v_; ss_ += v_ * v_; } } \
            ss_ += shx<1>(ss_); ss_ += shx<2>(ss_); \
            const float rs_ = __builtin_amdgcn_rsqf(ss_ * (1.0f / 128.0f) + NORM_EPS); \
            bf16* dst_ = R4 + (rowb0 + (size_t)(SHADOW == 2 ? 0 : (n_)) * CH + c_) * 1024 + colh + 32 * q4_; \
            _Pragma("unroll") for (int j_ = 0; j_ < 4; ++j_) { const unsigned zw_[4] = {pz[j_].x, pz[j_].y, pz[j_].z, pz[j_].w}; float y_[8]; \
                _Pragma("unroll") for (int e_ = 0; e_ < 8; ++e_) { const float zv_ = __builtin_bit_cast(float, (zw_[e_ >> 1] >> ((e_ & 1) * 16)) << 16); \
                    y_[e_] = ov_[8 * j_ + e_] * rs_ * GN[32 * q4_ + 8 * j_ + e_] * zv_ * __builtin_amdgcn_rcpf(1.0f + __expf(-zv_)); } \
                u32x4 w_; w_.x = pk2(y_[0], y_[1]); w_.y = pk2(y_[2], y_[3]); w_.z = pk2(y_[4], y_[5]); w_.w = pk2(y_[6], y_[7]); if (SHADOW == 0) *(u32x4*)(dst_ + 8 * j_) = w_; else asm volatile("" :: "v"(w_)); } } while (0)
        SCAN_LOAD_OPS(0); SCAN_STORE_OPS(0);
        SCAN_LOAD_OPS(1);
        WG_BARRIER();
        for (int n = 0; n < NCH; ++n) {
            asm volatile("" : "+v"(hid));
            PR_MARK(0);
            if (n > 0) SCAN_EPILOGUE(n - 1);
            PR_MARK(5);
            WG_BARRIER();
            PR_MARK(6);
            SCAN_STORE_OPS((n + 1) & 1);
            SCAN_LOAD_Z(n);
            { const int n2 = n + 2 < NCH ? n + 2 : NCH - 1; SCAN_LOAD_OPS(n2); }
            PR_MARK(7);
            WG_BARRIER();
            PR_MARK(8);
        }
        SCAN_EPILOGUE(NCH - 1);
        WG_BARRIER();
#undef SCAN_LOAD_OPS
#undef SCAN_STORE_OPS
#undef SCAN_LOAD_Z
#undef SCAN_EPILOGUE
    }
#ifdef PROBE_REGION
    if (SHADOW == 0 && blockIdx.x == 0 && wave == (PROBE_REGION <= 4 ? 0 : 4) && lane_id() == 0) ((volatile LAS unsigned long long*)(lds + LDS_BYTES - 128))[1] = pr_acc;
#endif
#undef PR_MARK
    __syncthreads();
}
__global__ void __launch_bounds__(NTHR, 2) hyb_fwd(Args args) {
    extern __shared__ __attribute__((aligned(16))) unsigned char lds_raw[];
    LAS unsigned char* lds = (LAS unsigned char*)lds_raw;
    const int wave = __builtin_amdgcn_readfirstlane((int)threadIdx.x >> 6);
    const int G = gridDim.x, bx = blockIdx.x, vcu = (G % 8 == 0) ? (bx % 8) * (G / 8) + bx / 8 : bx;
    const int lo = args.ph_lo, hi = args.ph_hi;
#ifdef PROBE_PHASE
    volatile LAS unsigned long long* PRB = (volatile LAS unsigned long long*)(lds + LDS_BYTES - 128);
    if (wave == 0 && lane_id() == 0) { PRB[0] = __builtin_amdgcn_s_memrealtime(); PRB[1] = 0ull; }
#define PSTAMP(k) do { if (wave == 0 && lane_id() == 0) { const unsigned long long now_ = __builtin_amdgcn_s_memrealtime(); if (PROBE_PHASE == (k)) PRB[1] = now_ - PRB[0]; PRB[0] = now_; } } while (0)
#else
#define PSTAMP(k) do { } while (0)
#endif
#define IN(k) (lo <= (k) && (k) < hi)
#if MK_N_LAUNCHES == 1
    volatile LAS unsigned* MISC = (volatile LAS unsigned*)(lds + LDS_BYTES - 256);
    if (wave == 0 && lane_id() < 2) MISC[lane_id()] = 0u;
    __syncthreads();
    const XcdBarrier bar = xcd_barrier_post((unsigned*)(args.ws + WS_CTL) + 4096, MISC, wave == 0 && lane_id() == 0);
#define SEAM(k) do { if (IN(k) && IN((k) + 1)) xcd_barrier(bar, wave == 0 && lane_id() == 0); } while (0)
#else
#define SEAM(k) do { } while (0)
#endif
    unsigned char* ws = args.ws; unsigned char* ob = (unsigned char*)args.out;
    bf16* HN = (bf16*)(ws + WS_HN);
    if (IN(PH_PRO)) { p0_prologue(args, lds, vcu, G, wave, lane_id()); }
    SEAM(PH_PRO); PSTAMP(PH_PRO);
    if (IN(PH_GEMM1)) {
        pg8::Gemm g{HN, (const bf16*)(ws + WS_W1T), M, N1, 1024}; pg8::StaticOrder S; S.init(M, N1, G, bx);
        pg8::EpiG1 E{(bf16*)(ob + OUT_SBQ), (bf16*)(ws + WS_R1), (bf16*)(ws + WS_R2), (bf16*)(ws + WS_R3), (bf16*)(ob + OUT_MQ), (bf16*)(ob + OUT_MZ)};
        pg8::gemm_phase<pg8::EpiG1, pg8::StaticOrder, true, true>(lds, g, S, E, wave);
        pg8::Gemm g2{(const bf16*)(ws + WS_MEMN), (const bf16*)(ws + WS_WMKVT), MROWS, 512, 1024}; pg8::StaticOrder S2; S2.init(MROWS, 512, G, G - 1 - bx);
        pg8::EpiMKV E2{(bf16*)(ws + WS_MK)};
        pg8::gemm_phase<pg8::EpiMKV, pg8::StaticOrder, true, true>(lds, g2, S2, E2, wave);
    }
    SEAM(PH_GEMM1); PSTAMP(PH_GEMM1);
    if (IN(PH_ATTN)) { p2_attention(args, lds, vcu, G, wave, lane_id()); }
    SEAM(PH_ATTN); PSTAMP(PH_ATTN);
    if (IN(PH_GEMM3)) {
        pg8::Gemm g{HN, (const bf16*)(ws + WS_W3T), M, N3, 1024}; pg8::StaticOrder S; S.init(M, N3, G, bx);
        pg8::EpiG3 E{(bf16*)(ws + WS_R1), (bf16*)(ws + WS_R2), (bf16*)(ws + WS_R3), (bf16*)(ws + WS_R4), (bf16*)(ws + WS_HALO)};
        pg8::gemm_phase<pg8::EpiG3, pg8::StaticOrder, true, true>(lds, g, S, E, wave);
    }
    SEAM(PH_GEMM3); PSTAMP(PH_GEMM3);
    if (IN(PH_PREP)) { for (int it = vcu; it < BATCH * NHEAD * NCH; it += G) dn_prep_item(args, lds, it, wave, lane_id()); __syncthreads(); }
    SEAM(PH_PREP); PSTAMP(PH_PREP);
#ifdef PROBE_SHADOW_SCAN
    if (IN(PH_SCAN)) { for (int u = bx; u < BATCH * NHEAD; u += G) dn_scan_unit<PROBE_SHADOW_SCAN>(args, lds, u, wave, lane_id()); }
#endif
    if (IN(PH_SCAN)) { for (int u = bx; u < BATCH * NHEAD; u += G) dn_scan_unit<0>(args, lds, u, wave, lane_id()); }
    SEAM(PH_SCAN); PSTAMP(PH_SCAN);
    if (IN(PH_MERGE)) {
        pg8::StaticOrder S; S.init(M, 1024, G, bx);
        bf16* Gs = (bf16*)(ws + WS_R1); float* Ms = (float*)(ws + WS_R2); bf16* MERGED = (bf16*)(ws + WS_R5);
        const bf16* WG = (const bf16*)(ws + WS_WGT);
        { pg8::Gemm g{HN, WG, M, 1024, 1024}; pg8::EpiGate E{Gs, 1024}; pg8::gemm_phase<pg8::EpiGate, pg8::StaticOrder, true, true>(lds, g, S, E, wave); }
        { pg8::Gemm g{(const bf16*)(ws + WS_R4), (const bf16*)(ws + WS_WBDN), M, 1024, 1024}; pg8::EpiMerge<0> E{Gs, Ms, MERGED, 1024}; pg8::gemm_phase<pg8::EpiMerge<0>, pg8::StaticOrder, true, true>(lds, g, S, E, wave); }
        { pg8::Gemm g{HN, WG + (size_t)1 * 1024 * 1024, M, 1024, 1024}; pg8::EpiGate E{Gs, 1024}; pg8::gemm_phase<pg8::EpiGate, pg8::StaticOrder, true, true>(lds, g, S, E, wave); }
        { pg8::Gemm g{(const bf16*)(ob + OUT_SBQ), (const bf16*)(ws + WS_WBSB), M, 1024, 1024}; pg8::EpiMerge<1> E{Gs, Ms, MERGED, 1024}; pg8::gemm_phase<pg8::EpiMerge<1>, pg8::StaticOrder, true, true>(lds, g, S, E, wave); }
        { pg8::Gemm g{HN, WG + (size_t)2 * 1024 * 1024, M, 1024, 1024}; pg8::EpiGate E{Gs, 1024}; pg8::gemm_phase<pg8::EpiGate, pg8::StaticOrder, true, true>(lds, g, S, E, wave); }
        { int k256 = 256; asm volatile("" : "+s"(k256));
          pg8::Gemm g{(const bf16*)(ob + OUT_MQ), (const bf16*)(ws + WS_WBM), M, 1024, k256}; pg8::EpiMerge<2> E{Gs, Ms, MERGED, 1024}; pg8::gemm_phase<pg8::EpiMerge<2>, pg8::StaticOrder, true, true>(lds, g, S, E, wave); }
    }
    SEAM(PH_MERGE); PSTAMP(PH_MERGE);
    if (IN(PH_OUT)) {
        pg8::StaticOrder S; S.init(M, 1024, G, bx);
        pg8::Gemm g{(const bf16*)(ws + WS_R5), (const bf16*)(ws + WS_WOUT), M, 1024, 1024}; pg8::EpiResid E{args.in[I_X], args.out, 1024};
        pg8::gemm_phase<pg8::EpiResid, pg8::StaticOrder, false, true>(lds, g, S, E, wave);
    }
    SEAM(PH_OUT); PSTAMP(PH_OUT);
    if (IN(PH_NORM)) { p8_final_norm(args, args.out, vcu, G, wave, lane_id()); }
    PSTAMP(PH_NORM);
#ifdef PROBE_PHASE
    if (bx == 0 && wave == 0 && lane_id() == 0) { const unsigned long long tdelta = PRB[1]; const unsigned long long s0 = __builtin_amdgcn_s_memrealtime(); while (__builtin_amdgcn_s_memrealtime() - s0 < tdelta) __builtin_amdgcn_s_sleep(8); }
#endif
#undef IN
#undef SEAM
}

extern "C" void kernel_launch(void* const* d_in, const int* in_sizes, int n_in, void* d_out, int out_size, void* d_ws, size_t ws_size, hipStream_t stream) {
    static int grid = 0;
    if (grid == 0) {
        if (n_in != 15 || in_sizes[0] != M * DM || out_size != M * DM || ws_size < WS_END) { fprintf(stderr, "kernel_launch: unexpected shapes (n_in %d, in0 %d, out %d, ws %zu)\n", n_in, n_in > 0 ? in_sizes[0] : -1, out_size, ws_size); grid = -1; return; }
        int dev = 0, cus = 0, per_cu = 0;
        if (hipGetDevice(&dev) != hipSuccess || hipDeviceGetAttribute(&cus, hipDeviceAttributeMultiprocessorCount, dev) != hipSuccess) { grid = -1; return; }
        if (hipFuncSetAttribute((const void*)hyb_fwd, hipFuncAttributeMaxDynamicSharedMemorySize, LDS_BYTES) != hipSuccess) { fprintf(stderr, "kernel_launch: hipFuncSetAttribute failed\n"); grid = -1; return; }
        if (hipOccupancyMaxActiveBlocksPerMultiprocessor(&per_cu, (const void*)hyb_fwd, NTHR, LDS_BYTES) != hipSuccess || per_cu < 1) { fprintf(stderr, "kernel_launch: occupancy query says %d blocks per CU\n", per_cu); (void)hipGetLastError(); grid = -1; return; }
        grid = cus * 1;
    }
    if (grid < 0) return;
    (void)hipMemsetAsync((char*)d_ws + WS_CTL, 0, CTL_ZERO_BYTES, stream);
    Args a{};
    for (int i = 0; i < 15; ++i) a.in[i] = (const float*)d_in[i];
    a.out = (float*)d_out; a.ws = (unsigned char*)d_ws;
#if MK_N_LAUNCHES == 1
    a.ph_lo = 0; a.ph_hi = PH_COUNT;
    void* kargs[] = {&a};
    hipError_t e = hipLaunchCooperativeKernel((const void*)hyb_fwd, dim3(grid), dim3(NTHR), kargs, LDS_BYTES, stream);
    if (e != hipSuccess) fprintf(stderr, "kernel_launch: cooperative launch failed: %s (grid %d)\n", hipGetErrorString(e), grid);
#else
    for (int p = 0; p < PH_COUNT; ++p) {
        a.ph_lo = p; a.ph_hi = p + 1;
        hipLaunchKernelGGL(hyb_fwd, dim3(grid), dim3(NTHR), LDS_BYTES, stream, a);
    }
#endif
}
```
